# Optimizing an MI355X kernel written in HIP

```python
import math
import jax, jax.numpy as jnp
from jax import lax
import numpy as np

D_MODEL = 1024
BATCH = 1
SEQ = 16384
DEPTH = 4
DEC_BATCH = 4
DEC_SEQ = 8192
PAST_LEN = 128

N_Q_HEADS = 8
N_KV_HEADS = 2
HEAD_DIM = 64
D_ATTN = N_Q_HEADS * HEAD_DIM
D_KV = N_KV_HEADS * HEAD_DIM
D_QKV = D_ATTN + 2 * D_KV
WINDOW = 128
BLOCK = 128
ROPE_THETA = 500000.0
ROPE_DIM = HEAD_DIM // 4
D_HYENA = 512
HYENA_GROUPS = 8
SHORT_CONV = 3
FILTER_EMB = 33
FILTER_HID = 64
FAST_DECAY_PCT = 0.3
SLOW_DECAY_PCT = 1.5
DECAY_TARGET = 1e-2
MAX_DECAY = math.log(DECAY_TARGET) / FAST_DECAY_PCT
MIN_DECAY = math.log(DECAY_TARGET) / SLOW_DECAY_PCT
D_MIX = D_ATTN + D_HYENA
D_IN = D_QKV + 3 * D_HYENA
D_FF = 2816
FFN_CONV = 3
D_PLE = 256
EPS = 1e-6

kernel_name = 'hybrid_hyena_swa_encoder'


def _rmsnorm(x, g):
    xf = x.astype(jnp.float32)
    y = xf * lax.rsqrt(jnp.mean(xf * xf, axis=-1, keepdims=True) + EPS)
    return (y * g.astype(jnp.float32)).astype(x.dtype)


def _dwconv3(x, w, b):
    xp = jnp.pad(x, ((0, 0), (1, 1), (0, 0)))
    return xp[:, :-2] * w[0] + xp[:, 1:-1] * w[1] + xp[:, 2:] * w[2] + b


def _rope_tables(L):
    inv = ROPE_THETA ** (-jnp.arange(0, ROPE_DIM, 2, dtype=jnp.float32) / ROPE_DIM)
    ang = jnp.arange(L, dtype=jnp.float32)[:, None] * inv[None]
    return jnp.cos(ang), jnp.sin(ang)


def _partial_rope(x, cos, sin):
    half = ROPE_DIM // 2
    xf = x.astype(jnp.float32)
    x1 = xf[..., :half]
    x2 = xf[..., half:ROPE_DIM]
    c = cos[None, :, None, :]
    s = sin[None, :, None, :]
    out = jnp.concatenate([x1 * c - x2 * s, x2 * c + x1 * s, xf[..., ROPE_DIM:]], axis=-1)
    return out.astype(x.dtype)


def _window_attention(q, k, v, sink):
    B, L = q.shape[0], q.shape[1]
    nb = L // BLOCK
    G = N_Q_HEADS // N_KV_HEADS
    qb = q.reshape(B, nb, BLOCK, N_KV_HEADS, G, HEAD_DIM)

    def band(t):
        tp = jnp.pad(t, ((0, 0), (BLOCK, BLOCK), (0, 0), (0, 0)))
        tp = tp.reshape(B, nb + 2, BLOCK, N_KV_HEADS, HEAD_DIM)
        return jnp.concatenate([tp[:, :-2], tp[:, 1:-1], tp[:, 2:]], axis=2)

    kb = band(k)
    vb = band(v)
    s = jnp.einsum('bnqhgd,bnkhd->bnhgqk', qb, kb,
                   preferred_element_type=jnp.float32) * (HEAD_DIM ** -0.5)
    qpos = jnp.arange(nb)[:, None, None] * BLOCK + jnp.arange(BLOCK)[None, :, None]
    kpos = jnp.arange(nb)[:, None, None] * BLOCK - BLOCK + jnp.arange(3 * BLOCK)[None, None, :]
    valid = (jnp.abs(kpos - qpos) <= WINDOW) & (kpos >= 0) & (kpos < L)
    s = jnp.where(valid[None, :, None, None], s, -1e30)
    sk = sink.astype(jnp.float32).reshape(N_KV_HEADS, G)[None, None, :, :, None, None]
    m = jnp.maximum(jnp.max(s, axis=-1, keepdims=True), sk)
    e = jnp.exp(s - m)
    pr = e / (jnp.sum(e, axis=-1, keepdims=True) + jnp.exp(sk - m))
    o = jnp.einsum('bnhgqk,bnkhd->bnqhgd', pr.astype(v.dtype), vb)
    return o.reshape(B, L, D_ATTN)


def _hyena_filter(L, w1, b1, fr1, w2, b2, fr2, w3):
    f32 = jnp.float32
    t = jnp.linspace(0.0, 1.0, L, dtype=f32)[:, None]
    bands = (FILTER_EMB - 1) // 2
    w = 2.0 * math.pi * jnp.arange(L, dtype=f32)[:, None] / L
    f = jnp.linspace(1e-4, bands - 1, bands, dtype=f32)[None]
    z = jnp.concatenate([t, jnp.cos(f * w), -jnp.sin(f * w)], axis=-1)
    hdn = jnp.sin(fr1.astype(f32) * (z @ w1.astype(f32) + b1.astype(f32)))
    hdn = jnp.sin(fr2.astype(f32) * (hdn @ w2.astype(f32) + b2.astype(f32)))
    h = (hdn @ w3.astype(f32)).reshape(L, 2, D_HYENA)
    deltas = jnp.linspace(MIN_DECAY, MAX_DECAY, D_HYENA, dtype=f32)
    decay = jnp.exp(-t * jnp.abs(deltas)[None])
    h = h * decay[:, None, :]
    return h[:, 0], h[:, 1]


def _bidir_long_conv(v, h_fwd, h_bwd, d_bias):
    B, L, C = v.shape
    f32 = jnp.float32
    k_full = jnp.concatenate([h_fwd, jnp.zeros((1, C), f32), h_bwd[:0:-1]], axis=0)
    kf = jnp.fft.rfft(k_full, n=2 * L, axis=0)
    vf32 = v.astype(f32)
    vf = jnp.fft.rfft(vf32, n=2 * L, axis=1)
    y = jnp.fft.irfft(vf * kf[None], n=2 * L, axis=1)[:, :L]
    return y + vf32 * d_bias.astype(f32)


def _trunk(x, p, weights):
    (rms_mix, w_in, q_norm, k_norm, sink, w_short, b_short,
     filt_w1, filt_b1, filt_freq1, filt_w2, filt_b2, filt_freq2, filt_w3, hyena_bias,
     norm_attn_out, norm_hyena_out, w_out, rms_ffn, w_up, w_ffconv, b_ffconv, w_down,
     w_ple_gate, w_ple_proj) = weights
    B, L, _ = x.shape
    cos, sin = _rope_tables(L)
    h = x
    for i in range(DEPTH):
        n = _rmsnorm(h, rms_mix[i])
        z = n @ w_in[i]
        q = z[..., :D_ATTN].reshape(B, L, N_Q_HEADS, HEAD_DIM)
        k = z[..., D_ATTN:D_ATTN + D_KV].reshape(B, L, N_KV_HEADS, HEAD_DIM)
        v = z[..., D_ATTN + D_KV:D_QKV].reshape(B, L, N_KV_HEADS, HEAD_DIM)
        q = _partial_rope(_rmsnorm(q, q_norm[i]), cos, sin)
        k = _partial_rope(_rmsnorm(k, k_norm[i]), cos, sin)
        attn = _window_attention(q, k, v, sink[i])
        u = _dwconv3(z[..., D_QKV:], w_short[i], b_short[i])
        x0, x1, hv = jnp.split(u, 3, axis=-1)
        hf, hb = _hyena_filter(L, filt_w1[i], filt_b1[i], filt_freq1[i],
                               filt_w2[i], filt_b2[i], filt_freq2[i], filt_w3[i])
        hy = x0.astype(jnp.float32) * _bidir_long_conv(x1 * hv, hf, hb, hyena_bias[i])
        hy = hy.astype(h.dtype)
        mix = jnp.concatenate([_rmsnorm(attn, norm_attn_out[i]),
                               _rmsnorm(hy, norm_hyena_out[i])], axis=-1)
        h = h + mix @ w_out[i]
        n2 = _rmsnorm(h, rms_ffn[i])
        uu = _dwconv3(n2 @ w_up[i], w_ffconv[i], b_ffconv[i])
        a, g = jnp.split(uu, 2, axis=-1)
        h = h + (jax.nn.silu(g) * a) @ w_down[i]
        h = h + jax.nn.sigmoid(h @ w_ple_gate[i]) * (p[i] @ w_ple_proj[i])
    return h


def setup_inputs(seed: int = 0) -> dict:
    key = jax.random.key(seed)
    ks = jax.random.split(key, 32)
    f32 = jnp.float32

    def nrm(k, shape, scale):
        return jax.random.normal(k, shape, f32) * scale

    def gain(k, shape):
        return 1.0 + 0.05 * jax.random.normal(k, shape, f32)

    return {
        'x_prompt': nrm(ks[0], (BATCH, SEQ, D_MODEL), 1.0),
        'x_sample': nrm(ks[1], (DEC_BATCH, DEC_SEQ, D_MODEL), 1.0),
        'p_prompt': nrm(ks[2], (DEPTH, BATCH, SEQ, D_PLE), 1.0),
        'p_sample': nrm(ks[3], (DEPTH, DEC_BATCH, DEC_SEQ, D_PLE), 1.0),
        'rms_mix': gain(ks[4], (DEPTH, D_MODEL)),
        'w_in': nrm(ks[5], (DEPTH, D_MODEL, D_IN), D_MODEL ** -0.5),
        'q_norm': gain(ks[6], (DEPTH, HEAD_DIM)),
        'k_norm': gain(ks[7], (DEPTH, HEAD_DIM)),
        'sink': nrm(ks[8], (DEPTH, N_Q_HEADS), 0.5),
        'w_short': nrm(ks[9], (DEPTH, SHORT_CONV, 3 * D_HYENA), SHORT_CONV ** -0.5),
        'b_short': nrm(ks[10], (DEPTH, 3 * D_HYENA), 0.02),
        'filt_w1': nrm(ks[11], (DEPTH, FILTER_EMB, FILTER_HID), FILTER_EMB ** -0.5),
        'filt_b1': nrm(ks[12], (DEPTH, FILTER_HID), 0.1),
        'filt_freq1': gain(ks[13], (DEPTH, FILTER_HID)),
        'filt_w2': nrm(ks[14], (DEPTH, FILTER_HID, FILTER_HID), FILTER_HID ** -0.5),
        'filt_b2': nrm(ks[15], (DEPTH, FILTER_HID), 0.1),
        'filt_freq2': gain(ks[16], (DEPTH, FILTER_HID)),
        'filt_w3': nrm(ks[17], (DEPTH, FILTER_HID, 2 * D_HYENA), FILTER_HID ** -0.5),
        'hyena_bias': nrm(ks[18], (DEPTH, D_HYENA), 0.5),
        'norm_attn_out': gain(ks[19], (DEPTH, D_ATTN)),
        'norm_hyena_out': gain(ks[20], (DEPTH, D_HYENA)),
        'w_out': nrm(ks[21], (DEPTH, D_MIX, D_MODEL), D_MIX ** -0.5),
        'rms_ffn': gain(ks[22], (DEPTH, D_MODEL)),
        'w_up': nrm(ks[23], (DEPTH, D_MODEL, 2 * D_FF), D_MODEL ** -0.5),
        'w_ffconv': nrm(ks[24], (DEPTH, FFN_CONV, 2 * D_FF), FFN_CONV ** -0.5),
        'b_ffconv': nrm(ks[25], (DEPTH, 2 * D_FF), 0.02),
        'w_down': nrm(ks[26], (DEPTH, D_FF, D_MODEL), D_FF ** -0.5),
        'w_ple_gate': nrm(ks[27], (DEPTH, D_MODEL, D_MODEL), D_MODEL ** -0.5),
        'w_ple_proj': nrm(ks[28], (DEPTH, D_PLE, D_MODEL), D_PLE ** -0.5),
    }


def reference(x_prompt, x_sample, p_prompt, p_sample, rms_mix, w_in, q_norm, k_norm, sink,
              w_short, b_short, filt_w1, filt_b1, filt_freq1, filt_w2, filt_b2, filt_freq2,
              filt_w3, hyena_bias, norm_attn_out, norm_hyena_out, w_out, rms_ffn, w_up,
              w_ffconv, b_ffconv, w_down, w_ple_gate, w_ple_proj):
    weights = (rms_mix, w_in, q_norm, k_norm, sink, w_short, b_short,
               filt_w1, filt_b1, filt_freq1, filt_w2, filt_b2, filt_freq2, filt_w3, hyena_bias,
               norm_attn_out, norm_hyena_out, w_out, rms_ffn, w_up, w_ffconv, b_ffconv, w_down,
               w_ple_gate, w_ple_proj)
    y_prompt = _trunk(x_prompt, p_prompt, weights)
    y_sample = _trunk(x_sample, p_sample, weights)
    return (y_prompt, y_sample)
```

```cpp
#include <hip/hip_runtime.h>
#include <hip/hip_cooperative_groups.h>
#include <cstdio>
#include <cstdint>
namespace cg = cooperative_groups;

#ifndef PROBE_MASK
#define PROBE_MASK 0
#endif

#define LAS __attribute__((address_space(3)))
typedef unsigned short bf16_t;
typedef short bf16x8 __attribute__((ext_vector_type(8)));
typedef float f32x4 __attribute__((ext_vector_type(4)));
typedef unsigned u32x4 __attribute__((ext_vector_type(4)));
typedef unsigned u32x2 __attribute__((ext_vector_type(2)));

constexpr int T = 49152, LP = 16384, LSQ = 8192, DM = 1024, DIN = 2304, DFF = 2816, NLAYER = 4;
constexpr float EPS = 1e-6f;
constexpr int LDS_BYTES = 159744;
constexpr int NPHASE = 1 + 9 * NLAYER;

constexpr size_t GUARD = 256 * 2048;
constexpr size_t SZ_HB = (size_t)T * DM * 2;
constexpr size_t OFF_X = GUARD;
constexpr size_t OFF_Y = OFF_X + SZ_HB + GUARD;
constexpr size_t OFF_ZA = OFF_Y + SZ_HB + GUARD;
constexpr size_t SZ_ZA = (size_t)T * DFF * 2;
constexpr size_t OFF_V = OFF_ZA + SZ_ZA;
constexpr size_t SZ_V = (size_t)T * 512 * 2;
constexpr size_t OFF_W = OFF_V + SZ_V;
constexpr size_t W_LAYER = 13369344;
constexpr size_t SZ_W = 2 * W_LAYER * 2;
constexpr size_t OFF_SSI = OFF_W + SZ_W;
constexpr size_t SZ_SS = (size_t)T * 16 * 4;
constexpr size_t OFF_SSF = OFF_SSI + SZ_SS;
constexpr size_t WS_END = OFF_SSF + SZ_SS;
constexpr size_t WO_IN = 0, WO_OUT = 2359296, WO_UP = 3407872, WO_DOWN = 9175040, WO_GATE = 12058624, WO_PROJ = 13107200;

struct P {
    const float *xp, *xs, *pp, *ps;
    const float *rms_mix, *w_in, *q_norm, *k_norm, *sink, *w_short, *b_short, *fw1, *fb1, *ffr1, *fw2, *fb2, *ffr2, *fw3, *hbias, *nao, *nho, *w_out, *rms_ffn, *w_up, *w_ffconv, *b_ffconv, *w_down, *w_gate, *w_proj;
    float* out;
    bf16_t *X, *Y, *ZA, *V, *W;
    float *ss_in, *ss_ffn;
    int nseq; int seq[125];
};

typedef const __attribute__((address_space(4))) P* KP;

__device__ __forceinline__ unsigned pk2(float lo, float hi) { unsigned r; asm volatile("v_cvt_pk_bf16_f32 %0, %1, %2" : "=v"(r) : "v"(lo), "v"(hi)); return r; }
__device__ __forceinline__ float bflo(unsigned u) { return __uint_as_float(u << 16); }
__device__ __forceinline__ float bfhi(unsigned u) { return __uint_as_float(u & 0xffff0000u); }
__device__ __forceinline__ float2 twid(float turns) { return make_float2(__builtin_amdgcn_cosf(turns), __builtin_amdgcn_sinf(turns)); }
__device__ __forceinline__ float2 twid_precise(float turns) { float s_, c_; sincospif(2.0f * turns, &s_, &c_); return make_float2(c_, s_); }
__device__ __forceinline__ float frcp(float x) { return 1.0f / x; }
__device__ __forceinline__ float rcp_nr(float x) { const float y = __builtin_amdgcn_rcpf(x); return __builtin_fmaf(y, __builtin_fmaf(-x, y, 1.0f), y); }
__device__ __forceinline__ float bf1(bf16_t h) { return __uint_as_float(((unsigned)h) << 16); }
__device__ __forceinline__ int otid(int wv) { unsigned z = 0; asm volatile("" : "+v"(z)); int t = wv * 64 + (int)__builtin_amdgcn_mbcnt_hi(~0u, __builtin_amdgcn_mbcnt_lo(~0u, z)); asm volatile("" : "+v"(t)); return t; }
__device__ __forceinline__ int obid() { int b = blockIdx.x; asm volatile("" : "+s"(b)); return b; }
__device__ __forceinline__ int ogrid() { int g = gridDim.x; asm volatile("" : "+s"(g)); return g; }
__device__ __forceinline__ float shx(float v, int mask, int lane) { return __int_as_float(__builtin_amdgcn_ds_bpermute((lane ^ mask) << 2, __float_as_int(v))); }
__device__ __forceinline__ float wave_sum(float v, int lane) {
#pragma unroll
    for (int o = 32; o >= 1; o >>= 1) v += shx(v, o, lane);
    return v;
}
__device__ __forceinline__ void seq_of(int t, int& sbase, int& L) {
    if (t < LP) { sbase = 0; L = LP; } else { sbase = LP + ((t - LP) / LSQ) * LSQ; L = LSQ; }
}

__device__ __forceinline__ void ph_xconv(KP p, int wv) {
    const int tid0 = otid(wv), wid = tid0 >> 6, lane = tid0 & 63;
    for (int t = obid() * 8 + wid; t < T; t += ogrid() * 8) {
        const float* src = t < LP ? p->xp + (size_t)t * DM : p->xs + (size_t)(t - LP) * DM;
        float ss = 0.f;
#pragma unroll
        for (int i = 0; i < 4; ++i) {
            f32x4 v = *(const f32x4*)(src + i * 256 + lane * 4);
            ss += v.x * v.x + v.y * v.y + v.z * v.z + v.w * v.w;
            u32x2 o; o.x = pk2(v.x, v.y); o.y = pk2(v.z, v.w);
            *(u32x2*)(p->Y + (size_t)t * DM + i * 256 + lane * 4) = o;
        }
        ss = wave_sum(ss, lane);
        if (lane < 16) p->ss_in[(size_t)t * 16 + lane] = lane == 0 ? ss : 0.f;
    }
}

__device__ __forceinline__ void ph_wconv(KP p, int l, unsigned char* sm, int wv) {
    float* tl = (float*)sm;
    bf16_t* Wl = p->W + (size_t)(l & 1) * W_LAYER;
    const int tid = otid(wv);
    for (int g = obid(); g < 3264; g += ogrid()) {
        const float* src; const float* gain = nullptr; bf16_t* dst; int K, N, tile;
        if (g < 576) { src = p->w_in + (size_t)l * 1024 * 2304; gain = p->rms_mix + l * 1024; dst = Wl + WO_IN; K = 1024; N = 2304; tile = g; }
        else if (g < 832) { src = p->w_out + (size_t)l * 1024 * 1024; dst = Wl + WO_OUT; K = 1024; N = 1024; tile = g - 576; }
        else if (g < 2240) { src = p->w_up + (size_t)l * 1024 * 5632; gain = p->rms_ffn + l * 1024; dst = Wl + WO_UP; K = 1024; N = 5632; tile = g - 832; }
        else if (g < 2944) { src = p->w_down + (size_t)l * 2816 * 1024; dst = Wl + WO_DOWN; K = 2816; N = 1024; tile = g - 2240; }
        else if (g < 3200) { src = p->w_gate + (size_t)l * 1024 * 1024; dst = Wl + WO_GATE; K = 1024; N = 1024; tile = g - 2944; }
        else { src = p->w_proj + (size_t)l * 256 * 1024; dst = Wl + WO_PROJ; K = 256; N = 1024; tile = g - 3200; }
        const int ntn = N / 64, k0 = (tile / ntn) * 64, n0 = (tile % ntn) * 64;
        __syncthreads();
#pragma unroll
        for (int i = 0; i < 8; ++i) {
            const int r = (tid >> 6) + 8 * i, c = tid & 63;
            float v = src[(size_t)(k0 + r) * N + n0 + c];
            if (gain) v *= gain[k0 + r];
            tl[r * 65 + c] = v;
        }
        __syncthreads();
#pragma unroll
        for (int i = 0; i < 8; ++i) {
            const int r = (tid >> 6) + 8 * i, c = tid & 63;
            unsigned pk = pk2(tl[c * 65 + r], 0.f);
            dst[(size_t)(n0 + r) * K + k0 + c] = (bf16_t)(pk & 0xffffu);
        }
    }
}

__device__ __forceinline__ void ph_pconv(KP p, int l, int wv) {
    for (int i = obid() * 512 + otid(wv); i < T * 32; i += ogrid() * 512) {
        const int t = i >> 5, c8 = (i & 31) * 8;
        const float* src = t < LP ? p->pp + ((size_t)l * LP + t) * 256 + c8 : p->ps + ((size_t)l * 32768 + (t - LP)) * 256 + c8;
        f32x4 a = *(const f32x4*)src, b = *(const f32x4*)(src + 4);
        u32x4 o; o.x = pk2(a.x, a.y); o.y = pk2(a.z, a.w); o.z = pk2(b.x, b.y); o.w = pk2(b.z, b.w);
        *(u32x4*)(p->V + (size_t)t * 256 + c8) = o;
    }
}

constexpr int BM = 256, BK = 64, HALF = 128, HTB = HALF * BK * 2, NXCD = 8, WGM = 4;
__device__ __forceinline__ int lds_byte(int r, int c) { const int st = (r >> 4) * 2 + (c >> 5), rr = r & 15, cc = c & 31, ob = rr * 64 + cc * 2; return st * 1024 + (ob ^ (((ob >> 9) & 1) << 5)); }
__device__ __forceinline__ void stage_rc(int b, int& R, int& C) { const int st = b / 1024, sb = b % 1024, swz = sb ^ (((sb >> 9) & 1) << 5); R = (st >> 1) * 16 + swz / 64; C = (st & 1) * 32 + (swz % 64) / 2; }
__device__ __forceinline__ int perm32(int rho) { const int n = rho >> 4, i = rho & 15; return 8 * (i >> 2) + 4 * n + (i & 3); }

struct Unit { int pm, pn; long arow; int b0, b1; };
struct Sched {
    int nM, nN, nwg, G, c, mode;
    __device__ __forceinline__ void init(int nM_, int nN_, int mode_) { nM = nM_; nN = nN_; nwg = nM * nN; G = ogrid(); c = obid(); mode = mode_; }
    __device__ __forceinline__ bool next(int i, Unit& u) const {
        const long Lx = (long)i * G + c; if (Lx >= nwg) return false;
        int wgid = (int)Lx; { const int q = nwg / NXCD, r = nwg % NXCD, xcd = wgid % NXCD, off = wgid / NXCD; wgid = (xcd < r ? xcd * (q + 1) : r * (q + 1) + (xcd - r) * q) + off; }
        const int nig = WGM * nN, gid = wgid / nig, fm = gid * WGM, gsz = (nM - fm) < WGM ? (nM - fm) : WGM;
        u.pm = fm + ((wgid % nig) % gsz); u.pn = (wgid % nig) / gsz;
        if (mode == 0) { u.arow = (long)u.pm * 256; u.b0 = u.pn * 256; u.b1 = u.pn * 256 + 128; }
        else {
            int sb, i2; if (u.pm < 65) { sb = 0; i2 = u.pm; } else { const int r = u.pm - 65; sb = LP + (r / 33) * LSQ; i2 = r % 33; }
            u.arow = (long)sb + 254 * i2 - 1; u.b0 = u.pn * 128; u.b1 = DFF + u.pn * 128;
        }
        return true;
    }
};

template <class Epi>
__device__ __forceinline__ void gemm_phase(LAS unsigned char* lds, const bf16_t* Ag, const bf16_t* Btg, const int K, const Sched& S, const Epi& E, int wv) {
    const int tid = otid(wv), wid = __builtin_amdgcn_readfirstlane(tid >> 6), lane = tid & 63, wr = wid >> 2, wc = wid & 3, fr = lane & 15, fq = lane >> 4;
    const int nt = K / BK;
    unsigned voffA[2], voffB[2];
#pragma unroll
    for (int i = 0; i < 2; ++i) { int R, C; stage_rc(tid * 16 + i * 8192, R, C); const int Rb = (R & ~31) + perm32(R & 31);
        voffA[i] = (unsigned)(R * K + C) * 2u; voffB[i] = (unsigned)(Rb * K + C) * 2u; }
    const size_t kstep = (size_t)(BK * 2);
    const size_t hstep = (size_t)HALF * K * 2;
    const size_t rowb = (size_t)K * 2;
    const unsigned ldsw = (unsigned)wid * 1024u;
    const int aoff = lds_byte(wr * 64 + fr, fq * 8), boff = lds_byte(wc * 32 + fr, fq * 8);
#define G_SA(b, h) (((b) * 2 + (h)) * HTB)
#define G_SB(b, h) ((4 + (b) * 2 + (h)) * HTB)
#define G_STAGE(bufoff, gbase, voff) do { const char* _gb = (const char*)(gbase); asm volatile("" : "+s"(_gb)); _Pragma("unroll") for (int _i = 0; _i < 2; ++_i) \
        __builtin_amdgcn_global_load_lds((const unsigned*)(_gb + (voff)[_i]), (LAS unsigned*)(lds + (bufoff) + ldsw + _i * 8192), 16, 0, 0); } while (0)
#define G_LDA(dst, b, h) do { _Pragma("unroll") for (int m = 0; m < 4; ++m) _Pragma("unroll") for (int k = 0; k < 2; ++k) dst[m][k] = *(const LAS bf16x8*)(lds + G_SA(b, h) + aoff + m * 2048 + k * 1024); } while (0)
#define G_LDB(dst, b, h) do { _Pragma("unroll") for (int n = 0; n < 2; ++n) _Pragma("unroll") for (int k = 0; k < 2; ++k) dst[n][k] = *(const LAS bf16x8*)(lds + G_SB(b, h) + boff + n * 2048 + k * 1024); } while (0)
#define G_MMA(ai, bj, At, Bt) do { __builtin_amdgcn_s_setprio(1); _Pragma("unroll") for (int m = 0; m < 4; ++m) _Pragma("unroll") for (int n = 0; n < 2; ++n) _Pragma("unroll") for (int k = 0; k < 2; ++k) \
        acc[ai][bj][m][n] = __builtin_amdgcn_mfma_f32_16x16x32_bf16(Bt[n][k], At[m][k], acc[ai][bj][m][n], 0, 0, 0); __builtin_amdgcn_s_setprio(0); } while (0)
#define G_WAIT_V(n) asm volatile("s_waitcnt vmcnt(" #n ")" ::: "memory")
#define G_WAIT_L(n) asm volatile("s_waitcnt lgkmcnt(" #n ")" ::: "memory")
#define G_BAR __builtin_amdgcn_s_barrier()
#define G_SCHED __builtin_amdgcn_sched_barrier(0)
    Unit cur, nxt; int ui = 0;
    if (!S.next(0, cur)) return;
    f32x4 acc[2][2][4][2];
#pragma unroll
    for (int a = 0; a < 2; ++a)
#pragma unroll
        for (int b = 0; b < 2; ++b)
#pragma unroll
            for (int m = 0; m < 4; ++m)
#pragma unroll
                for (int n = 0; n < 2; ++n) acc[a][b][m][n] = (f32x4){0.f, 0.f, 0.f, 0.f};
    bf16x8 At[4][2], B0[2][2], B1[2][2];
    const char* cA = (const char*)Ag + cur.arow * (long)rowb;
    const char* cB0 = (const char*)Btg + (size_t)cur.b0 * rowb;
    const char* cB1 = (const char*)Btg + (size_t)cur.b1 * rowb;
    G_STAGE(G_SB(0, 0), cB0, voffB); G_STAGE(G_SA(0, 0), cA, voffA); G_STAGE(G_SB(0, 1), cB1, voffB); G_STAGE(G_SA(0, 1), cA + hstep, voffA);
    if (wr == 1) G_BAR;
    G_WAIT_V(4); G_BAR;
    G_STAGE(G_SB(1, 0), cB0 + kstep, voffB); G_STAGE(G_SA(1, 0), cA + kstep, voffA); G_STAGE(G_SB(1, 1), cB1 + kstep, voffB);
    G_WAIT_V(6); G_BAR;
    for (;;) {
        const bool has_next = S.next(ui + 1, nxt);
        const char* nA = has_next ? (const char*)Ag + nxt.arow * (long)rowb : cA;
        const char* nB0 = has_next ? (const char*)Btg + (size_t)nxt.b0 * rowb : cB0;
        const char* nB1 = has_next ? (const char*)Btg + (size_t)nxt.b1 * rowb : cB1;
        for (int t = 0; t < nt; t += 2) {
            const bool last = (t == nt - 2);
            const char* a1 = cA + (size_t)(t + 1) * kstep;
            const char* a2 = last ? nA : cA + (size_t)(t + 2) * kstep;
            const char* b20 = last ? nB0 : cB0 + (size_t)(t + 2) * kstep;
            const char* b21 = last ? nB1 : cB1 + (size_t)(t + 2) * kstep;
            const char* a3 = a2 + kstep; const char* b30 = b20 + kstep; const char* b31 = b21 + kstep;
            G_LDB(B0, 0, 0); G_SCHED; G_LDA(At, 0, 0); G_STAGE(G_SA(1, 1), a1 + hstep, voffA);
            G_WAIT_L(8); G_BAR; G_WAIT_L(0); G_MMA(0, 0, At, B0); G_BAR; G_SCHED;
            G_LDB(B1, 0, 1); G_STAGE(G_SB(0, 0), b20, voffB);
            G_BAR; G_WAIT_L(0); G_MMA(0, 1, At, B1); G_BAR;
            G_LDA(At, 0, 1); G_STAGE(G_SA(0, 0), a2, voffA);
            G_BAR; G_WAIT_L(0); G_MMA(1, 0, At, B0); G_BAR; G_SCHED;
            G_STAGE(G_SB(0, 1), b21, voffB);
            G_WAIT_V(6); G_BAR; G_MMA(1, 1, At, B1); G_BAR;
            G_LDB(B0, 1, 0); G_SCHED; G_LDA(At, 1, 0); G_STAGE(G_SA(0, 1), a2 + hstep, voffA);
            G_WAIT_L(8); G_BAR; G_WAIT_L(0); G_MMA(0, 0, At, B0); G_BAR; G_SCHED;
            G_LDB(B1, 1, 1); G_STAGE(G_SB(1, 0), b30, voffB);
            G_BAR; G_WAIT_L(0); G_MMA(0, 1, At, B1); G_BAR;
            G_LDA(At, 1, 1); G_STAGE(G_SA(1, 0), a3, voffA);
            G_BAR; G_WAIT_L(0); G_MMA(1, 0, At, B0); G_BAR; G_SCHED;
            G_STAGE(G_SB(1, 1), b31, voffB);
            G_WAIT_V(6); G_BAR; G_MMA(1, 1, At, B1); G_BAR;
        }
        E(acc, cur, wr, wc, fr, fq, lds);
        if (!has_next) break;
#pragma unroll
        for (int a = 0; a < 2; ++a)
#pragma unroll
            for (int b = 0; b < 2; ++b)
#pragma unroll
                for (int m = 0; m < 4; ++m)
#pragma unroll
                    for (int n = 0; n < 2; ++n) acc[a][b][m][n] = (f32x4){0.f, 0.f, 0.f, 0.f};
        cur = nxt; cA = nA; cB0 = nB0; cB1 = nB1; ++ui;
    }
    G_WAIT_V(0);
    if (wr == 0) G_BAR;
    G_BAR;
#undef G_SA
#undef G_SB
#undef G_STAGE
#undef G_LDA
#undef G_LDB
#undef G_MMA
}

constexpr int EPI_XB = 131072, EPI_RS = 131072 + 4096, EPI_CW = 131072 + 5120;
__device__ __forceinline__ void stage_rstd(LAS unsigned char* lds, const float* ss, int tid, long grow0, int sr0, int L) {
    if (tid < 256) {
        const int sr = sr0 + tid; const bool valid = sr >= 0 && sr < L;
        const f32x4* q = (const f32x4*)(ss + (size_t)(valid ? grow0 + tid : 0) * 16);
        const f32x4 a = q[0], b = q[1], c = q[2], d = q[3];
        const float sm_ = ((a.x + a.y) + (a.z + a.w)) + ((b.x + b.y) + (b.z + b.w)) + ((c.x + c.y) + (c.z + c.w)) + ((d.x + d.y) + (d.z + d.w));
        ((LAS float*)(lds + EPI_RS))[tid] = valid ? rsqrtf(sm_ * (1.0f / 1024.0f) + EPS) : 0.f;
    }
}
#define EPI_SYNC() do { asm volatile("s_waitcnt lgkmcnt(0)" ::: "memory"); __builtin_amdgcn_s_barrier(); __builtin_amdgcn_s_barrier(); asm volatile("" ::: "memory"); } while (0)

struct EpiIn {
    bf16_t* Z; const float* ss;
    __device__ __forceinline__ void operator()(f32x4 (&acc)[2][2][4][2], const Unit& u, int wr, int wc, int fr, int fq, LAS unsigned char* lds) const {
        asm volatile("" : "+v"(fr), "+v"(fq), "+s"(wr), "+s"(wc));
        const int tid = (wr * 4 + wc) * 64 + fq * 16 + fr;
        stage_rstd(lds, ss, tid, (long)u.pm * 256, 0, 1 << 30);
        EPI_SYNC();
        const LAS float* rs = (const LAS float*)(lds + EPI_RS);
        const int row0 = u.pm * 256 + wr * 64 + fr, col0 = wc * 32 + 8 * fq;
#pragma unroll
        for (int ai = 0; ai < 2; ++ai)
#pragma unroll
            for (int m = 0; m < 4; ++m) {
                const int row = row0 + ai * 128 + m * 16; const float r = rs[128 * ai + 64 * wr + 16 * m + fr];
#pragma unroll
                for (int bj = 0; bj < 2; ++bj) {
                    const f32x4 v0 = acc[ai][bj][m][0] * r, v1 = acc[ai][bj][m][1] * r;
                    u32x4 o; o.x = pk2(v0.x, v0.y); o.y = pk2(v0.z, v0.w); o.z = pk2(v1.x, v1.y); o.w = pk2(v1.z, v1.w);
                    *(u32x4*)(Z + (size_t)row * DIN + (bj ? u.b1 : u.b0) + col0) = o;
                }
            }
    }
};
struct EpiRes {
    const float* xp; const float* xs; const bf16_t* rsrc; bf16_t* hb; float* ss; int mode;
    __device__ __forceinline__ void operator()(f32x4 (&acc)[2][2][4][2], const Unit& u, int wr, int wc, int fr, int fq, LAS unsigned char*) const {
        asm volatile("" : "+v"(fr), "+v"(fq), "+s"(wr), "+s"(wc));
        const int row0 = u.pm * 256 + wr * 64 + fr, col0 = wc * 32 + 8 * fq;
#pragma unroll
        for (int ai = 0; ai < 2; ++ai) {
            __builtin_amdgcn_sched_barrier(0);
            f32x4 rv[4][2][2];
            if (mode == 0) {
#pragma unroll
                for (int m = 0; m < 4; ++m) {
                    const int row = row0 + ai * 128 + m * 16;
                    const float* rp = row < LP ? xp + (size_t)row * DM : xs + (size_t)(row - LP) * DM;
#pragma unroll
                    for (int bj = 0; bj < 2; ++bj) { const int col = (bj ? u.b1 : u.b0) + col0; rv[m][bj][0] = *(const f32x4*)(rp + col); rv[m][bj][1] = *(const f32x4*)(rp + col + 4); }
                }
            } else {
                u32x4 rb[4][2];
#pragma unroll
                for (int m = 0; m < 4; ++m)
#pragma unroll
                    for (int bj = 0; bj < 2; ++bj) rb[m][bj] = *(const u32x4*)(rsrc + (size_t)(row0 + ai * 128 + m * 16) * DM + (bj ? u.b1 : u.b0) + col0);
#pragma unroll
                for (int m = 0; m < 4; ++m)
#pragma unroll
                    for (int bj = 0; bj < 2; ++bj) {
                        const u32x4 q = rb[m][bj];
                        rv[m][bj][0] = (f32x4){bflo(q.x), bfhi(q.x), bflo(q.y), bfhi(q.y)}; rv[m][bj][1] = (f32x4){bflo(q.z), bfhi(q.z), bflo(q.w), bfhi(q.w)};
                    }
            }
            __builtin_amdgcn_sched_barrier(0);
#pragma unroll
            for (int m = 0; m < 4; ++m) {
                const int row = row0 + ai * 128 + m * 16;
                float sq = 0.f;
#pragma unroll
                for (int bj = 0; bj < 2; ++bj) {
                    const int col = (bj ? u.b1 : u.b0) + col0;
                    const f32x4 h0 = rv[m][bj][0] + acc[ai][bj][m][0], h1 = rv[m][bj][1] + acc[ai][bj][m][1];
                    sq += h0.x * h0.x + h0.y * h0.y + h0.z * h0.z + h0.w * h0.w + h1.x * h1.x + h1.y * h1.y + h1.z * h1.z + h1.w * h1.w;
                    u32x4 o; o.x = pk2(h0.x, h0.y); o.y = pk2(h0.z, h0.w); o.z = pk2(h1.x, h1.y); o.w = pk2(h1.z, h1.w);
                    *(u32x4*)(hb + (size_t)row * DM + col) = o;
                }
                if (ss) { sq += shx(sq, 16, fq * 16 + fr); sq += shx(sq, 32, fq * 16 + fr); if (fq == 0) ss[(size_t)row * 16 + u.pn * 4 + wc] = sq; }
            }
        }
    }
};
struct EpiGate {
    bf16_t* Sg;
    __device__ __forceinline__ void operator()(f32x4 (&acc)[2][2][4][2], const Unit& u, int wr, int wc, int fr, int fq, LAS unsigned char*) const {
        asm volatile("" : "+v"(fr), "+v"(fq), "+s"(wr), "+s"(wc));
        const int row0 = u.pm * 256 + wr * 64 + fr, col0 = wc * 32 + 8 * fq;
#pragma unroll
        for (int ai = 0; ai < 2; ++ai)
#pragma unroll
            for (int m = 0; m < 4; ++m) {
                __builtin_amdgcn_sched_barrier(0); const int row = row0 + ai * 128 + m * 16;
#pragma unroll
                for (int bj = 0; bj < 2; ++bj) {
                    float s[8];
#pragma unroll
                    for (int n = 0; n < 2; ++n)
#pragma unroll
                        for (int j = 0; j < 4; ++j) s[n * 4 + j] = rcp_nr(1.0f + fminf(__expf(-acc[ai][bj][m][n][j]), 1e30f));
                    u32x4 o; o.x = pk2(s[0], s[1]); o.y = pk2(s[2], s[3]); o.z = pk2(s[4], s[5]); o.w = pk2(s[6], s[7]);
                    *(u32x4*)(Sg + (size_t)row * DM + (bj ? u.b1 : u.b0) + col0) = o;
                }
            }
    }
};
struct EpiProj {
    const bf16_t* Sg; const bf16_t* hbx; float* out; bf16_t* hb; float* ss; int last;
    __device__ __forceinline__ void operator()(f32x4 (&acc)[2][2][4][2], const Unit& u, int wr, int wc, int fr, int fq, LAS unsigned char*) const {
        asm volatile("" : "+v"(fr), "+v"(fq), "+s"(wr), "+s"(wc));
        const int row0 = u.pm * 256 + wr * 64 + fr, col0 = wc * 32 + 8 * fq;
#pragma unroll
        for (int ai = 0; ai < 2; ++ai)
#pragma unroll
            for (int mp = 0; mp < 2; ++mp) {
                __builtin_amdgcn_sched_barrier(0);
                u32x4 sgv[2][2], ovb[2][2]; f32x4 ov[2][2][2];
#pragma unroll
                for (int mm = 0; mm < 2; ++mm) {
                    const int row = row0 + ai * 128 + (mp * 2 + mm) * 16;
#pragma unroll
                    for (int bj = 0; bj < 2; ++bj) {
                        const int col = (bj ? u.b1 : u.b0) + col0;
                        sgv[mm][bj] = *(const u32x4*)(Sg + (size_t)row * DM + col);
                        ovb[mm][bj] = *(const u32x4*)(hbx + (size_t)row * DM + col);
                    }
                }
                __builtin_amdgcn_sched_barrier(0);
#pragma unroll
                for (int mm = 0; mm < 2; ++mm)
#pragma unroll
                    for (int bj = 0; bj < 2; ++bj) {
                        const u32x4 q = ovb[mm][bj];
                        ov[mm][bj][0] = (f32x4){bflo(q.x), bfhi(q.x), bflo(q.y), bfhi(q.y)}; ov[mm][bj][1] = (f32x4){bflo(q.z), bfhi(q.z), bflo(q.w), bfhi(q.w)};
                    }
#pragma unroll
                for (int mm = 0; mm < 2; ++mm) {
                    const int m = mp * 2 + mm, row = row0 + ai * 128 + m * 16;
                    float sq = 0.f;
#pragma unroll
                    for (int bj = 0; bj < 2; ++bj) {
                        const int col = (bj ? u.b1 : u.b0) + col0;
                        const u32x4 sg = sgv[mm][bj];
                        f32x4 g0, g1; g0.x = bflo(sg.x); g0.y = bfhi(sg.x); g0.z = bflo(sg.y); g0.w = bfhi(sg.y); g1.x = bflo(sg.z); g1.y = bfhi(sg.z); g1.z = bflo(sg.w); g1.w = bfhi(sg.w);
                        const f32x4 h0 = ov[mm][bj][0] + g0 * acc[ai][bj][m][0], h1 = ov[mm][bj][1] + g1 * acc[ai][bj][m][1];
                        if (last) { float* op = out + (size_t)row * DM + col; *(f32x4*)op = h0; *(f32x4*)(op + 4) = h1; }
                        sq += h0.x * h0.x + h0.y * h0.y + h0.z * h0.z + h0.w * h0.w + h1.x * h1.x + h1.y * h1.y + h1.z * h1.z + h1.w * h1.w;
                        if (!last) { u32x4 o; o.x = pk2(h0.x, h0.y); o.y = pk2(h0.z, h0.w); o.z = pk2(h1.x, h1.y); o.w = pk2(h1.z, h1.w); *(u32x4*)(hb + (size_t)row * DM + col) = o; }
                    }
                    sq += shx(sq, 16, fq * 16 + fr); sq += shx(sq, 32, fq * 16 + fr); if (fq == 0 && !last) ss[(size_t)row * 16 + u.pn * 4 + wc] = sq;
                }
            }
    }
};
__device__ __forceinline__ unsigned dppu_ror1(unsigned x) { return (unsigned)__builtin_amdgcn_update_dpp(0, (int)x, 0x121, 0xf, 0xf, false); }
__device__ __forceinline__ unsigned dppu_ror15(unsigned x) { return (unsigned)__builtin_amdgcn_update_dpp(0, (int)x, 0x12F, 0xf, 0xf, false); }
struct EpiUp {
    bf16_t* act; const float* ss; const float* w3; const float* b3;
    __device__ __forceinline__ void operator()(f32x4 (&acc)[2][2][4][2], const Unit& u, int wr, int wc, int fr, int fq, LAS unsigned char* lds) const {
        asm volatile("" : "+v"(fr), "+v"(fq), "+s"(wr), "+s"(wc));
        int sb, L, i2; if (u.pm < 65) { sb = 0; L = LP; i2 = u.pm; } else { const int r = u.pm - 65; sb = LP + (r / 33) * LSQ; L = LSQ; i2 = r % 33; }
        const int sr0 = 254 * i2 - 1;
        const int tid = (wr * 4 + wc) * 64 + fq * 16 + fr;
        stage_rstd(lds, ss, tid, (long)sb + sr0, sr0, L);
        {
            LAS float* cw = (LAS float*)(lds + EPI_CW);
#pragma unroll
            for (int i = 0; i < 2; ++i) {
                const int e = tid + 512 * i, bj = e >> 9, k = (e >> 7) & 3, c = e & 127;
                cw[e] = k < 3 ? w3[k * 2 * DFF + bj * DFF + u.b0 + c] : b3[bj * DFF + u.b0 + c];
            }
        }
        EPI_SYNC();
        const LAS float* rs = (const LAS float*)(lds + EPI_RS);
        unsigned pq[2][2][4][2][2];
#pragma unroll
        for (int ai = 0; ai < 2; ++ai)
#pragma unroll
            for (int m = 0; m < 4; ++m) {
                const float r = rs[128 * ai + 64 * wr + 16 * m + fr];
#pragma unroll
                for (int bj = 0; bj < 2; ++bj)
#pragma unroll
                    for (int n = 0; n < 2; ++n) {
                        const f32x4 v = acc[ai][bj][m][n];
                        pq[ai][bj][m][n][0] = r != 0.f ? pk2(v.x * r, v.y * r) : 0u;
                        pq[ai][bj][m][n][1] = r != 0.f ? pk2(v.z * r, v.w * r) : 0u;
                    }
            }
        LAS unsigned* xb = (LAS unsigned*)(lds + EPI_XB);
        const int clp = 16 * wc + 4 * fq;
        if (fr == 0) {
#pragma unroll
            for (int ai = 0; ai < 2; ++ai)
#pragma unroll
                for (int bj = 0; bj < 2; ++bj)
#pragma unroll
                    for (int n = 0; n < 2; ++n) { u32x2 t; t.x = pq[ai][bj][0][n][0]; t.y = pq[ai][bj][0][n][1]; *(LAS u32x2*)(xb + ((ai * 2 + wr) * 2 + 0) * 128 + 64 * bj + clp + 2 * n) = t; }
        }
        if (fr == 15) {
#pragma unroll
            for (int ai = 0; ai < 2; ++ai)
#pragma unroll
                for (int bj = 0; bj < 2; ++bj)
#pragma unroll
                    for (int n = 0; n < 2; ++n) { u32x2 t; t.x = pq[ai][bj][3][n][0]; t.y = pq[ai][bj][3][n][1]; *(LAS u32x2*)(xb + ((ai * 2 + wr) * 2 + 1) * 128 + 64 * bj + clp + 2 * n) = t; }
        }
        EPI_SYNC();
        constexpr bool r1prev = true;
        const int cl = 32 * wc + 8 * fq;
#pragma unroll
        for (int ai = 0; ai < 2; ++ai) {
            const int pa = wr ? ai : ai - 1, pw = wr ? 0 : 1, na = wr ? ai + 1 : ai, nw = wr ? 0 : 1;
            const bool hasp = pa >= 0 && fr == 0, hasn = na < 2 && fr == 15;
            unsigned outp[4][4];
#pragma unroll
            for (int n = 0; n < 2; ++n) {
                const LAS unsigned* xp_ = xb + (((pa < 0 ? 0 : pa) * 2 + pw) * 2 + 1) * 128 + clp + 2 * n;
                const LAS unsigned* xn_ = xb + (((na > 1 ? 1 : na) * 2 + nw) * 2 + 0) * 128 + clp + 2 * n;
#pragma unroll
                for (int jp = 0; jp < 2; ++jp) {
                    __builtin_amdgcn_sched_barrier(0);
                    float ag[2][4][2];
#pragma unroll
                    for (int bj = 0; bj < 2; ++bj) {
                        const LAS float* cwp = (const LAS float*)(lds + EPI_CW) + bj * 512 + cl + 4 * n + 2 * jp;
                        const float w0a = cwp[0], w0b = cwp[1], w1a = cwp[128], w1b = cwp[129], w2a = cwp[256], w2b = cwp[257], bba = cwp[384], bbb = cwp[385];
                        const unsigned hpv = hasp ? xp_[64 * bj + jp] : 0u, hnv = hasn ? xn_[64 * bj + jp] : 0u;
                        unsigned cv[4], ra[4], rb[4];
#pragma unroll
                        for (int m = 0; m < 4; ++m) { cv[m] = pq[ai][bj][m][n][jp]; const unsigned x1 = dppu_ror1(cv[m]), x15 = dppu_ror15(cv[m]); ra[m] = r1prev ? x1 : x15; rb[m] = r1prev ? x15 : x1; }
#pragma unroll
                        for (int m = 0; m < 4; ++m) {
                            const unsigned pv = fr > 0 ? ra[m] : (m > 0 ? ra[m > 0 ? m - 1 : 0] : hpv);
                            const unsigned nv = fr < 15 ? rb[m] : (m < 3 ? rb[m < 3 ? m + 1 : 3] : hnv);
                            ag[bj][m][0] = w0a * bflo(pv) + w1a * bflo(cv[m]) + w2a * bflo(nv) + bba;
                            ag[bj][m][1] = w0b * bfhi(pv) + w1b * bfhi(cv[m]) + w2b * bfhi(nv) + bbb;
                        }
                    }
#pragma unroll
                    for (int m = 0; m < 4; ++m) {
                        const float r0 = ag[0][m][0] * ag[1][m][0] * rcp_nr(1.0f + fminf(__expf(-ag[1][m][0]), 1e30f)), r1 = ag[0][m][1] * ag[1][m][1] * rcp_nr(1.0f + fminf(__expf(-ag[1][m][1]), 1e30f));
                        outp[m][2 * n + jp] = pk2(r0, r1);
                    }
                }
            }
#pragma unroll
            for (int m = 0; m < 4; ++m) {
                const int rt = 128 * ai + 64 * wr + 16 * m + fr, sr = sr0 + rt;
                if (rt >= 1 && rt <= 254 && sr < L) { u32x4 o; o.x = outp[m][0]; o.y = outp[m][1]; o.z = outp[m][2]; o.w = outp[m][3]; *(u32x4*)(act + (size_t)(sb + sr) * DFF + u.b0 + cl) = o; }
            }
        }
    }
};

__device__ __forceinline__ void unpack16(const u32x4& a, const u32x4& b, float (&x)[16]) {
    x[0] = bflo(a.x); x[1] = bfhi(a.x); x[2] = bflo(a.y); x[3] = bfhi(a.y); x[4] = bflo(a.z); x[5] = bfhi(a.z); x[6] = bflo(a.w); x[7] = bfhi(a.w);
    x[8] = bflo(b.x); x[9] = bfhi(b.x); x[10] = bflo(b.y); x[11] = bfhi(b.y); x[12] = bflo(b.z); x[13] = bfhi(b.z); x[14] = bflo(b.w); x[15] = bfhi(b.w);
}
__device__ __forceinline__ void qk_prep_store(u32x4 a, u32x4 b, const float* gain, int sub, int pos, float scale, bf16_t* dst, int lane) {
    float x[16]; unpack16(a, b, x);
    float ss = 0.f;
#pragma unroll
    for (int i = 0; i < 16; ++i) ss += x[i] * x[i];
    ss += shx(ss, 1, lane); ss += shx(ss, 2, lane);
    const float r = rsqrtf(ss * (1.0f / 64.0f) + EPS);
#pragma unroll
    for (int i = 0; i < 16; ++i) x[i] = x[i] * r * gain[sub * 16 + i];
    if (sub == 0) {
        const float ihi[8] = {(float)(1.0 / 3.14159265358979323846), (float)(0.19392274474868576 / 3.14159265358979323846), (float)(0.03760603093086393 / 3.14159265358979323846), (float)(0.007292664737217109 / 3.14159265358979323846),
                              (float)(0.001414213562373095 / 3.14159265358979323846), (float)(0.0002742481756762073 / 3.14159265358979323846), (float)(5.318295896944988e-05 / 3.14159265358979323846), (float)(1.031338537721246e-05 / 3.14159265358979323846)};
        const float ilo[8] = {(float)(1.0 / 3.14159265358979323846 - (double)(float)(1.0 / 3.14159265358979323846)), (float)(0.19392274474868576 / 3.14159265358979323846 - (double)(float)(0.19392274474868576 / 3.14159265358979323846)),
                              (float)(0.03760603093086393 / 3.14159265358979323846 - (double)(float)(0.03760603093086393 / 3.14159265358979323846)), (float)(0.007292664737217109 / 3.14159265358979323846 - (double)(float)(0.007292664737217109 / 3.14159265358979323846)),
                              (float)(0.001414213562373095 / 3.14159265358979323846 - (double)(float)(0.001414213562373095 / 3.14159265358979323846)), (float)(0.0002742481756762073 / 3.14159265358979323846 - (double)(float)(0.0002742481756762073 / 3.14159265358979323846)),
                              (float)(5.318295896944988e-05 / 3.14159265358979323846 - (double)(float)(5.318295896944988e-05 / 3.14159265358979323846)), (float)(1.031338537721246e-05 / 3.14159265358979323846 - (double)(float)(1.031338537721246e-05 / 3.14159265358979323846))};
#pragma unroll
        for (int j = 0; j < 8; ++j) {
            const float fp = (float)pos, ph = fp * ihi[j], pe = __builtin_fmaf(fp, ihi[j], -ph) + fp * ilo[j];
            const float red = (ph - 2.0f * rintf(0.5f * ph)) + pe;
            const float2 cs = twid_precise(0.5f * red); const float c = cs.x, s = cs.y;
            const float x1 = x[j], x2 = x[8 + j];
            x[j] = x1 * c - x2 * s; x[8 + j] = x2 * c + x1 * s;
        }
    }
    u32x4 o0, o1;
    o0.x = pk2(x[0] * scale, x[1] * scale); o0.y = pk2(x[2] * scale, x[3] * scale); o0.z = pk2(x[4] * scale, x[5] * scale); o0.w = pk2(x[6] * scale, x[7] * scale);
    o1.x = pk2(x[8] * scale, x[9] * scale); o1.y = pk2(x[10] * scale, x[11] * scale); o1.z = pk2(x[12] * scale, x[13] * scale); o1.w = pk2(x[14] * scale, x[15] * scale);
    *(u32x4*)dst = o0; *(u32x4*)(dst + 8) = o1;
}

__device__ __forceinline__ void ph_attn(KP p, int l, unsigned char* sm, int wv) {
    bf16_t* Ks = (bf16_t*)sm;
    bf16_t* Vt = (bf16_t*)(sm + 57600);
    bf16_t* Qs = (bf16_t*)(sm + 57600 + 51712);
    const bf16_t* Z = p->ZA;
    const int tid = otid(wv), wid = tid >> 6, lane = tid & 63, fr = lane & 15, fq = lane >> 4;
    const float* qg = p->q_norm + l * 64; const float* kg = p->k_norm + l * 64;
    for (int item0 = obid(); item0 < 768; item0 += ogrid()) {
        const int item = ogrid() == 256 ? (item0 & 7) * 96 + (item0 >> 8) * 32 + ((item0 & 255) >> 3) : item0;
        const int kvh = item / 384, qb = item - kvh * 384, Q0 = qb * 128;
        int sbase, L; seq_of(Q0, sbase, L);
        const int Q0rel = Q0 - sbase;
        const bool interior = Q0rel >= 128 && Q0rel + 256 <= L;
        __syncthreads();
        {
            u32x4 ka[4], kb[4], va[4], vb[4];
#pragma unroll
            for (int it = 0; it < 4; ++it) {
                const int idx = tid + 512 * it, row = idx >> 2, sub = idx & 3, prel = Q0rel - 128 + row;
                const bool inb = idx < 1600 && row < 384 && prel >= 0 && prel < L;
                ka[it] = (u32x4){0u, 0u, 0u, 0u}; kb[it] = ka[it]; va[it] = ka[it]; vb[it] = ka[it];
                if (inb) {
                    const bf16_t* src = Z + (size_t)(sbase + prel) * DIN + 512 + kvh * 64 + sub * 16;
                    ka[it] = *(const u32x4*)src; kb[it] = *(const u32x4*)(src + 8);
                    va[it] = *(const u32x4*)(src + 128); vb[it] = *(const u32x4*)(src + 136);
                }
            }
#pragma unroll
            for (int it = 0; it < 4; ++it) {
                const int idx = tid + 512 * it, row = idx >> 2, sub = idx & 3, prel = Q0rel - 128 + row;
                if (idx < 1600) {
                    qk_prep_store(ka[it], kb[it], kg, sub, prel, 1.0f, Ks + row * 72 + sub * 16, lane);
                    const unsigned vv[8] = {va[it].x, va[it].y, va[it].z, va[it].w, vb[it].x, vb[it].y, vb[it].z, vb[it].w};
#pragma unroll
                    for (int i = 0; i < 8; ++i) {
                        Vt[(sub * 16 + 2 * i) * 404 + row] = (bf16_t)(vv[i] & 0xffffu);
                        Vt[(sub * 16 + 2 * i + 1) * 404 + row] = (bf16_t)(vv[i] >> 16);
                    }
                }
            }
        }
        u32x4 qa[4], qb2[4];
#pragma unroll
        for (int g = 0; g < 4; ++g) {
            const bf16_t* src = Z + (size_t)(Q0 + (tid >> 2)) * DIN + (kvh * 4 + g) * 64 + (tid & 3) * 16;
            qa[g] = *(const u32x4*)src; qb2[g] = *(const u32x4*)(src + 8);
        }
        for (int g = 0; g < 4; ++g) {
            const int h = kvh * 4 + g;
            __syncthreads();
            {
                const int row = tid >> 2, sub = tid & 3;
                const u32x4 qsa = g == 0 ? qa[0] : (g == 1 ? qa[1] : (g == 2 ? qa[2] : qa[3])), qsb = g == 0 ? qb2[0] : (g == 1 ? qb2[1] : (g == 2 ? qb2[2] : qb2[3]));
                qk_prep_store(qsa, qsb, qg, sub, Q0rel + row, 0.125f, Qs + row * 72 + sub * 16, lane);
            }
            __syncthreads();
            bf16x8 qf[2];
#pragma unroll
            for (int ks = 0; ks < 2; ++ks) qf[ks] = *(const bf16x8*)(Qs + (16 * wid + fr) * 72 + 32 * ks + 8 * fq);
            f32x4 o[4];
#pragma unroll
            for (int dt = 0; dt < 4; ++dt) o[dt] = (f32x4){0.f, 0.f, 0.f, 0.f};
            float mrun = p->sink[l * 8 + h];
            float lsum = fq == 0 ? 1.0f : 0.0f;
            const int qi = 16 * wid + fr;
            for (int s = 0; s < 9; ++s) {
                const int kk0 = 16 * wid + 32 * s;
                f32x4 st[2];
#pragma unroll
                for (int kt = 0; kt < 2; ++kt) {
                    st[kt] = (f32x4){0.f, 0.f, 0.f, 0.f};
#pragma unroll
                    for (int ks = 0; ks < 2; ++ks) {
                        const bf16x8 kf = *(const bf16x8*)(Ks + (kk0 + 16 * kt + fr) * 72 + 32 * ks + 8 * fq);
                        st[kt] = __builtin_amdgcn_mfma_f32_16x16x32_bf16(kf, qf[ks], st[kt], 0, 0, 0);
                    }
                }
                float sv[2][4]; float mx = -1e30f;
                if (interior && s >= 1 && s <= 7) {
#pragma unroll
                    for (int kt = 0; kt < 2; ++kt)
#pragma unroll
                        for (int r = 0; r < 4; ++r) { sv[kt][r] = st[kt][r]; mx = fmaxf(mx, sv[kt][r]); }
                } else {
#pragma unroll
                    for (int kt = 0; kt < 2; ++kt)
#pragma unroll
                        for (int r = 0; r < 4; ++r) {
                            const int kk = kk0 + 16 * kt + 4 * fq + r, d = kk - 128 - qi, prel = Q0rel + kk - 128;
                            const bool valid = d >= -128 && d <= 128 && prel >= 0 && prel < L && kk < 384;
                            sv[kt][r] = valid ? st[kt][r] : -1e30f;
                            mx = fmaxf(mx, sv[kt][r]);
                        }
                }
                mx = fmaxf(mx, shx(mx, 16, lane)); mx = fmaxf(mx, shx(mx, 32, lane));
                const float mn = fmaxf(mrun, mx), alpha = __expf(mrun - mn);
                mrun = mn;
                float pr[2][4], psum = 0.f;
#pragma unroll
                for (int kt = 0; kt < 2; ++kt)
#pragma unroll
                    for (int r = 0; r < 4; ++r) { pr[kt][r] = __expf(sv[kt][r] - mn); psum += pr[kt][r]; }
                lsum = lsum * alpha + psum;
                union { bf16x8 v; unsigned u[4]; } pf;
                pf.u[0] = pk2(pr[0][0], pr[0][1]); pf.u[1] = pk2(pr[0][2], pr[0][3]); pf.u[2] = pk2(pr[1][0], pr[1][1]); pf.u[3] = pk2(pr[1][2], pr[1][3]);
#pragma unroll
                for (int dt = 0; dt < 4; ++dt) {
                    o[dt] = o[dt] * alpha;
                    union { bf16x8 v; u32x2 h[2]; } vf;
                    vf.h[0] = *(const u32x2*)(Vt + (16 * dt + fr) * 404 + kk0 + 4 * fq);
                    vf.h[1] = *(const u32x2*)(Vt + (16 * dt + fr) * 404 + kk0 + 16 + 4 * fq);
                    o[dt] = __builtin_amdgcn_mfma_f32_16x16x32_bf16(vf.v, pf.v, o[dt], 0, 0, 0);
                }
            }
            lsum += shx(lsum, 16, lane); lsum += shx(lsum, 32, lane);
            const float il = frcp(lsum);
            bf16_t* dst = p->Y + (size_t)(Q0 + qi) * DM + h * 64 + 4 * fq;
#pragma unroll
            for (int dt = 0; dt < 4; ++dt) { u32x2 w; w.x = pk2(o[dt].x * il, o[dt].y * il); w.y = pk2(o[dt].z * il, o[dt].w * il); *(u32x2*)(dst + 16 * dt) = w; }
        }
    }
}

__device__ __forceinline__ void ph_hyena_pre(KP p, int l, unsigned char* sm, int wv) {
    constexpr int ZS = 513;
    unsigned* zt = (unsigned*)sm;
    bf16_t* vt = (bf16_t*)(sm + 34 * ZS * 4);
    float* cw = (float*)(sm + 34 * ZS * 4 + 512 * 80);
    const bf16_t* Z = p->ZA;
    const int tid = otid(wv), tt = tid & 31, cg = tid >> 5;
    const float* ws = p->w_short + (size_t)l * 3 * 1536; const float* bs = p->b_short + l * 1536;
    __syncthreads();
    cw[tid] = ws[512 + tid]; cw[512 + tid] = ws[1536 + 512 + tid]; cw[1024 + tid] = ws[3072 + 512 + tid]; cw[1536 + tid] = bs[512 + tid];
    cw[2048 + tid] = ws[1024 + tid]; cw[2560 + tid] = ws[1536 + 1024 + tid]; cw[3072 + tid] = ws[3072 + 1024 + tid]; cw[3584 + tid] = bs[1024 + tid];
    u32x4 pre[9];
    {
        const int t0 = obid() * 32; int sbase, L; seq_of(t0, sbase, L);
#pragma unroll
        for (int i = 0; i < 9; ++i) {
            const int q = tid + 512 * i, r = q >> 7, ch = q & 127, t = t0 - 1 + r;
            pre[i] = (u32x4){0u, 0u, 0u, 0u};
            if (q < 34 * 128 && t >= sbase && t < sbase + L) pre[i] = *(const u32x4*)(Z + (size_t)t * DIN + 1280 + ch * 8);
        }
    }
    for (int tile = obid(); tile < 1536; tile += ogrid()) {
        const int t0 = tile * 32;
        __syncthreads();
#pragma unroll
        for (int i = 0; i < 9; ++i) {
            const int q = tid + 512 * i, r = q >> 7, ch = q & 127;
            if (q < 34 * 128) { unsigned* d = zt + r * ZS + ch * 4; d[0] = pre[i].x; d[1] = pre[i].y; d[2] = pre[i].z; d[3] = pre[i].w; }
        }
        __syncthreads();
        {
            const int tn = tile + ogrid();
            if (tn < 1536) {
                const int t0n = tn * 32; int sbn, Ln; seq_of(t0n, sbn, Ln);
#pragma unroll
                for (int i = 0; i < 9; ++i) {
                    const int q = tid + 512 * i, r = q >> 7, ch = q & 127, t = t0n - 1 + r;
                    pre[i] = (u32x4){0u, 0u, 0u, 0u};
                    if (q < 34 * 128 && t >= sbn && t < sbn + Ln) pre[i] = *(const u32x4*)(Z + (size_t)t * DIN + 1280 + ch * 8);
                }
            }
        }
#pragma unroll 4
        for (int i = 0; i < 16; ++i) {
            const int c = cg * 32 + 2 * i;
            const unsigned a_p = zt[tt * ZS + (c >> 1)], a_c = zt[(tt + 1) * ZS + (c >> 1)], a_n = zt[(tt + 2) * ZS + (c >> 1)];
            const unsigned g_p = zt[tt * ZS + 256 + (c >> 1)], g_c = zt[(tt + 1) * ZS + 256 + (c >> 1)], g_n = zt[(tt + 2) * ZS + 256 + (c >> 1)];
            const float u1a = cw[c] * bflo(a_p) + cw[512 + c] * bflo(a_c) + cw[1024 + c] * bflo(a_n) + cw[1536 + c];
            const float u2a = cw[2048 + c] * bflo(g_p) + cw[2560 + c] * bflo(g_c) + cw[3072 + c] * bflo(g_n) + cw[3584 + c];
            const float u1b = cw[c + 1] * bfhi(a_p) + cw[513 + c] * bfhi(a_c) + cw[1025 + c] * bfhi(a_n) + cw[1537 + c];
            const float u2b = cw[2049 + c] * bfhi(g_p) + cw[2561 + c] * bfhi(g_c) + cw[3073 + c] * bfhi(g_n) + cw[3585 + c];
            const unsigned pk = pk2(u1a * u2a, u1b * u2b);
            vt[c * 40 + tt] = (bf16_t)(pk & 0xffffu); vt[(c + 1) * 40 + tt] = (bf16_t)(pk >> 16);
        }
        __syncthreads();
#pragma unroll
        for (int i = 0; i < 4; ++i) {
            const int q = tid + 512 * i, cc = q >> 2, part = q & 3;
            *(u32x4*)(p->V + (size_t)cc * T + t0 + part * 8) = *(const u32x4*)(vt + cc * 40 + part * 8);
        }
    }
}

__device__ __forceinline__ void ph_filtergen(KP p, int l, unsigned char* sm, int wv) {
    float* zf = (float*)sm;
    float* h1 = zf + 64 * 34;
    float* h2 = h1 + 64 * 65;
    float* w1s = h2 + 64 * 68;
    float* w2s = w1s + 33 * 64;
    float* ot = w2s + 64 * 64;
    const int tid = otid(wv), wid = tid >> 6, lane = tid & 63;
    const float* b1 = p->fb1 + l * 64; const float* f1 = p->ffr1 + l * 64;
    const float* b2 = p->fb2 + l * 64; const float* f2 = p->ffr2 + l * 64;
    const float* w3 = p->fw3 + (size_t)l * 65536; const float* hb = p->hbias + l * 512;
    __syncthreads();
    for (int i = tid; i < 33 * 64; i += 512) w1s[i] = p->fw1[l * 33 * 64 + i];
    for (int i = tid; i < 64 * 64; i += 512) w2s[i] = p->fw2[l * 4096 + i];
    for (int item = obid(); item < 384; item += ogrid()) {
        const int L = item < 256 ? LP : LSQ, n0 = (item < 256 ? item : item - 256) * 64;
        bf16_t* kf = p->X + (item < 256 ? 0 : 16777216);
        __syncthreads();
        {
            const int n = n0 + lane;
            const float w = 2.0f * (float)n / (float)L;
#pragma unroll
            for (int q = 0; q < 2; ++q) {
                const int b = wid * 2 + q;
                const float f = 1e-4f + (float)b * 0.9999933333333334f;
                const float ht = f * w, red = ht - 2.0f * rintf(0.5f * ht);
                const float2 cs = twid_precise(0.5f * red);
                zf[lane * 34 + 1 + b] = cs.x; zf[lane * 34 + 17 + b] = -cs.y;
            }
            if (wid == 0) zf[lane * 34] = (float)n / (float)(L - 1);
        }
        __syncthreads();
        {
            float a[8];
#pragma unroll
            for (int i = 0; i < 8; ++i) a[i] = b1[wid * 8 + i];
#pragma unroll 3
            for (int f = 0; f < 33; ++f) {
                const float zv = zf[lane * 34 + f];
                const f32x4 w0 = *(const f32x4*)(w1s + f * 64 + wid * 8), w1v = *(const f32x4*)(w1s + f * 64 + wid * 8 + 4);
                a[0] += zv * w0.x; a[1] += zv * w0.y; a[2] += zv * w0.z; a[3] += zv * w0.w; a[4] += zv * w1v.x; a[5] += zv * w1v.y; a[6] += zv * w1v.z; a[7] += zv * w1v.w;
            }
#pragma unroll
            for (int i = 0; i < 8; ++i) h1[lane * 65 + wid * 8 + i] = sinpif(f1[wid * 8 + i] * a[i] * 0.3183098861837907f);
        }
        __syncthreads();
        {
            float a[8];
#pragma unroll
            for (int i = 0; i < 8; ++i) a[i] = b2[wid * 8 + i];
#pragma unroll 4
            for (int j = 0; j < 64; ++j) {
                const float zv = h1[lane * 65 + j];
                const f32x4 w0 = *(const f32x4*)(w2s + j * 64 + wid * 8), w1v = *(const f32x4*)(w2s + j * 64 + wid * 8 + 4);
                a[0] += zv * w0.x; a[1] += zv * w0.y; a[2] += zv * w0.z; a[3] += zv * w0.w; a[4] += zv * w1v.x; a[5] += zv * w1v.y; a[6] += zv * w1v.z; a[7] += zv * w1v.w;
            }
#pragma unroll
            for (int i = 0; i < 8; ++i) h2[lane * 68 + wid * 8 + i] = sinpif(f2[wid * 8 + i] * a[i] * 0.3183098861837907f);
        }
        __syncthreads();
#pragma unroll 1
        for (int pass = 0; pass < 4; ++pass) {
            const int ol = tid & 255, o = pass * 256 + ol, ph0 = (tid >> 8) * 32;
            float wcol[64];
#pragma unroll
            for (int j = 0; j < 64; ++j) wcol[j] = w3[j * 1024 + o];
#pragma unroll 2
            for (int pp = 0; pp < 32; ++pp) {
                const f32x4* hr = (const f32x4*)(h2 + (ph0 + pp) * 68);
                float acc0 = 0.f, acc1 = 0.f;
#pragma unroll
                for (int j4 = 0; j4 < 16; ++j4) { const f32x4 hv = hr[j4]; acc0 += hv.x * wcol[j4 * 4] + hv.z * wcol[j4 * 4 + 2]; acc1 += hv.y * wcol[j4 * 4 + 1] + hv.w * wcol[j4 * 4 + 3]; }
                ot[ol * 65 + ph0 + pp] = acc0 + acc1;
            }
            __syncthreads();
            for (int e = tid; e < 256 * 64; e += 512) {
                const int ol2 = e >> 6, pos = e & 63, o2 = pass * 256 + ol2, c = o2 & 511, n = n0 + pos;
                const float tt = (float)n / (float)(L - 1);
                const float delta = fabsf(-3.070113457325394f + (float)c * ((-15.350567286626971f + 3.070113457325394f) / 511.0f));
                float val = ot[ol2 * 65 + pos] * __expf(-tt * delta);
                bf16_t* kc = kf + (size_t)c * (2 * L);
                if (o2 < 512) { if (n == 0) val += hb[c]; kc[n] = (bf16_t)(pk2(val, 0.f) & 0xffffu); }
                else { if (n >= 1) kc[2 * L - n] = (bf16_t)(pk2(val, 0.f) & 0xffffu); else kc[L] = (bf16_t)0; }
            }
            __syncthreads();
        }
    }
}

__device__ __forceinline__ float2 cmul(float2 a, float2 b) { return make_float2(a.x * b.x - a.y * b.y, a.x * b.y + a.y * b.x); }
__device__ __forceinline__ float2 cadd(float2 a, float2 b) { return make_float2(a.x + b.x, a.y + b.y); }
__device__ __forceinline__ float2 csub(float2 a, float2 b) { return make_float2(a.x - b.x, a.y - b.y); }

__device__ __forceinline__ int PD(int i) { return i + (i >> 4); }
template <bool TW>
__device__ __forceinline__ void fft16_fwd(float2 (&x)[16], float2 T1) {
    const float C[8] = {1.0f, 0.92387953251128674f, 0.70710678118654752f, 0.38268343236508977f, 0.0f, -0.38268343236508977f, -0.70710678118654752f, -0.92387953251128674f};
    const float S[8] = {0.0f, 0.38268343236508977f, 0.70710678118654752f, 0.92387953251128674f, 1.0f, 0.92387953251128674f, 0.70710678118654752f, 0.38268343236508977f};
    float2 Ts = T1;
#pragma unroll
    for (int st = 0; st < 4; ++st) {
        const int half = 8 >> st;
#pragma unroll
        for (int i = 0; i < 8; ++i) {
            const int g = i / half, j = i % half, pp = g * 2 * half + j, ti = j * (8 / half);
            const float2 a = x[pp], b = x[pp + half], d = csub(a, b);
            x[pp] = cadd(a, b);
            const float2 dw = cmul(d, make_float2(C[ti], -S[ti]));
            x[pp + half] = TW ? cmul(dw, Ts) : dw;
        }
        if (TW) Ts = cmul(Ts, Ts);
    }
}
template <bool TW>
__device__ __forceinline__ void fft16_inv(float2 (&x)[16], float2 T1c) {
    const float C[8] = {1.0f, 0.92387953251128674f, 0.70710678118654752f, 0.38268343236508977f, 0.0f, -0.38268343236508977f, -0.70710678118654752f, -0.92387953251128674f};
    const float S[8] = {0.0f, 0.38268343236508977f, 0.70710678118654752f, 0.92387953251128674f, 1.0f, 0.92387953251128674f, 0.70710678118654752f, 0.38268343236508977f};
    const float2 T2 = cmul(T1c, T1c), T4 = cmul(T2, T2), T8 = cmul(T4, T4);
#pragma unroll
    for (int st = 0; st < 4; ++st) {
        const int half = 1 << st;
        const float2 Ts = st == 0 ? T8 : (st == 1 ? T4 : (st == 2 ? T2 : T1c));
#pragma unroll
        for (int i = 0; i < 8; ++i) {
            const int g = i / half, j = i % half, pp = g * 2 * half + j, ti = j * (8 / half);
            const float2 bw = cmul(x[pp + half], make_float2(C[ti], S[ti]));
            const float2 a = x[pp], b = TW ? cmul(bw, Ts) : bw;
            x[pp] = cadd(a, b); x[pp + half] = csub(a, b);
        }
    }
}
template <bool FWD>
__device__ __forceinline__ void fft_pass16(float2* z, int Lc, int ls, int tid) {
    const int s = 1 << ls, os = ls >= 4 ? s + (s >> 4) : 1;
    const float its = 0.0625f / (float)s;
    for (int q = tid; q < (Lc >> 4); q += 512) {
        const int g = q >> ls, j = q & (s - 1), pb = PD((g << (ls + 4)) + j);
        float2 x[16];
#pragma unroll
        for (int k = 0; k < 16; ++k) x[k] = z[pb + k * os];
        if (ls == 0) { if (FWD) fft16_fwd<false>(x, make_float2(1.f, 0.f)); else fft16_inv<false>(x, make_float2(1.f, 0.f)); }
        else { const float2 T1 = twid((FWD ? -1.0f : 1.0f) * (float)j * its); if (FWD) fft16_fwd<true>(x, T1); else fft16_inv<true>(x, T1); }
#pragma unroll
        for (int k = 0; k < 16; ++k) z[pb + k * os] = x[k];
    }
    __syncthreads();
}
__device__ __forceinline__ void fft_fwd(float2* z, int lg, int tid) {
    const int Lc = 1 << lg; const int lh = lg - 1;
    if (lg & 1) {
        const int h = 1 << lh, oh = h + (h >> 4);
        for (int j = tid; j < h; j += 512) {
            const int pj = PD(j);
            const float2 a = z[pj], b = z[pj + oh];
            z[pj] = cadd(a, b); z[pj + oh] = cmul(csub(a, b), twid(-(float)j * (0.5f / (float)h)));
        }
        __syncthreads();
    } else {
        const int h = 1 << lh, hh = h >> 1, oh = h + (h >> 4), ohh = hh + (hh >> 4);
        const float ih2 = 0.5f / (float)h;
        for (int q0 = tid; q0 < (Lc >> 2); q0 += 2048) {
            float2 x[4][4]; int pbs[4]; float2 w1s[4];
#pragma unroll
            for (int u = 0; u < 4; ++u) {
                const int q = q0 + 512 * u, g = q >> (lh - 1), j = q & (hh - 1), pb = PD((g << (lh + 1)) + j);
                pbs[u] = pb; w1s[u] = twid(-(float)j * ih2);
                x[u][0] = z[pb]; x[u][1] = z[pb + ohh]; x[u][2] = z[pb + oh]; x[u][3] = z[pb + oh + ohh];
            }
#pragma unroll
            for (int u = 0; u < 4; ++u) {
                const float2 w1 = w1s[u], w2 = cmul(w1, w1);
                const float2 a0 = cadd(x[u][0], x[u][2]), a2 = cmul(csub(x[u][0], x[u][2]), w1), a1 = cadd(x[u][1], x[u][3]), t3 = cmul(csub(x[u][1], x[u][3]), w1);
                const float2 a3 = make_float2(t3.y, -t3.x);
                x[u][0] = cadd(a0, a1); x[u][1] = cmul(csub(a0, a1), w2); x[u][2] = cadd(a2, a3); x[u][3] = cmul(csub(a2, a3), w2);
            }
#pragma unroll
            for (int u = 0; u < 4; ++u) { const int pb = pbs[u]; z[pb] = x[u][0]; z[pb + ohh] = x[u][1]; z[pb + oh] = x[u][2]; z[pb + oh + ohh] = x[u][3]; }
        }
        __syncthreads();
    }
    fft_pass16<true>(z, Lc, 8, tid);
    fft_pass16<true>(z, Lc, 4, tid);
    fft_pass16<true>(z, Lc, 0, tid);
}
__device__ __forceinline__ void fft_inv(float2* z, int lg, int tid) {
    const int Lc = 1 << lg; const int lh = 12;
    fft_pass16<false>(z, Lc, 0, tid);
    fft_pass16<false>(z, Lc, 4, tid);
    fft_pass16<false>(z, Lc, 8, tid);
    if (lg & 1) {
        const int h = 1 << lh, oh = h + (h >> 4);
        for (int j = tid; j < h; j += 512) {
            const int pj = PD(j);
            const float2 a = z[pj], b = cmul(z[pj + oh], twid((float)j * (0.5f / (float)h)));
            z[pj] = cadd(a, b); z[pj + oh] = csub(a, b);
        }
        __syncthreads();
    } else {
        const int h = 1 << lh, oh = h + (h >> 4);
        const float ih4 = 0.25f / (float)h;
        for (int q0 = tid; q0 < (Lc >> 2); q0 += 2048) {
            float2 x[4][4]; int pbs[4]; float2 cws[4];
#pragma unroll
            for (int u = 0; u < 4; ++u) {
                const int q = q0 + 512 * u, g = q >> lh, j = q & (h - 1), pb = PD((g << (lh + 2)) + j);
                pbs[u] = pb; cws[u] = twid((float)j * ih4);
                x[u][0] = z[pb]; x[u][1] = z[pb + oh]; x[u][2] = z[pb + 2 * oh]; x[u][3] = z[pb + 3 * oh];
            }
#pragma unroll
            for (int u = 0; u < 4; ++u) {
                const float2 cwb = cws[u], cwa = cmul(cwb, cwb);
                const float2 t1 = cmul(x[u][1], cwa), a0 = cadd(x[u][0], t1), a1 = csub(x[u][0], t1), t3 = cmul(x[u][3], cwa), a2 = cadd(x[u][2], t3), a3 = csub(x[u][2], t3);
                const float2 u2 = cmul(a2, cwb), u3t = cmul(a3, cwb), u3 = make_float2(-u3t.y, u3t.x);
                x[u][0] = cadd(a0, u2); x[u][2] = csub(a0, u2); x[u][1] = cadd(a1, u3); x[u][3] = csub(a1, u3);
            }
#pragma unroll
            for (int u = 0; u < 4; ++u) { const int pb = pbs[u]; z[pb] = x[u][0]; z[pb + oh] = x[u][1]; z[pb + 2 * oh] = x[u][2]; z[pb + 3 * oh] = x[u][3]; }
        }
        __syncthreads();
    }
}

__device__ __forceinline__ void ph_filter_fft(KP p, unsigned char* sm, int wv) {
    float2* z = (float2*)sm;
    const int tid = otid(wv);
    for (int item = obid(); item < 1024; item += ogrid()) {
        const int big = item < 512, c = item & 511, lg = big ? 14 : 13, Lc = 1 << lg;
        unsigned* g = (unsigned*)p->X + (big ? 0 : 8388608) + (size_t)c * Lc;
        __syncthreads();
#pragma unroll 4
        for (int i = tid; i < (Lc >> 2); i += 512) {
            const u32x4 v = *(const u32x4*)(g + 4 * i); const int pi = PD(4 * i);
            z[pi] = make_float2(bflo(v.x), bfhi(v.x)); z[pi + 1] = make_float2(bflo(v.y), bfhi(v.y)); z[pi + 2] = make_float2(bflo(v.z), bfhi(v.z)); z[pi + 3] = make_float2(bflo(v.w), bfhi(v.w));
        }
        __syncthreads();
        fft_fwd(z, lg, tid);
        const float sc = 1.0f / (float)Lc;
        for (int k = tid; k <= (Lc >> 1); k += 512) {
            if (k == 0) { const float2 Z0 = z[0]; g[0] = pk2((Z0.x + Z0.y) * sc, (Z0.x - Z0.y) * sc); continue; }
            const int pk = (int)(__brev((unsigned)k) >> (32 - lg)), pm = (int)(__brev((unsigned)(Lc - k)) >> (32 - lg));
            const float2 Zk = z[PD(pk)], Zm = z[PD(pm)];
            const float2 E = make_float2(0.5f * (Zk.x + Zm.x), 0.5f * (Zk.y - Zm.y));
            const float2 O = make_float2(0.5f * (Zk.y + Zm.y), -0.5f * (Zk.x - Zm.x));
            const float2 wO = cmul(twid(-(float)k * (0.5f / (float)Lc)), O);
            const float2 Xk = cadd(E, wO), Xm0 = csub(E, wO);
            g[k] = pk2(Xk.x * sc, Xk.y * sc);
            g[Lc - k] = pk2(Xm0.x * sc, -Xm0.y * sc);
        }
    }
}

template <int LG>
__device__ __forceinline__ void pair_one(float2* z, int k, float2 Kk, float2 Km) {
    constexpr int Lc = 1 << LG;
    const int pk = (int)(__brev((unsigned)k) >> (32 - LG)), pm = (int)(__brev((unsigned)(Lc - k)) >> (32 - LG));
    const float2 Zk = z[PD(pk)], Zm = z[PD(pm)];
    const float2 E = make_float2(0.5f * (Zk.x + Zm.x), 0.5f * (Zk.y - Zm.y));
    const float2 O = make_float2(0.5f * (Zk.y + Zm.y), -0.5f * (Zk.x - Zm.x));
    const float2 w = twid(-(float)k * (0.5f / (float)Lc));
    const float2 wO = cmul(w, O);
    const float2 Xk = cadd(E, wO), Xm0 = csub(E, wO), Xm = make_float2(Xm0.x, -Xm0.y);
    const float2 Yk = cmul(Xk, Kk), Ym = cmul(Xm, Km);
    const float2 E2 = make_float2(0.5f * (Yk.x + Ym.x), 0.5f * (Yk.y - Ym.y));
    const float2 D2 = make_float2(0.5f * (Yk.x - Ym.x), 0.5f * (Yk.y + Ym.y));
    const float2 O2 = cmul(D2, make_float2(w.x, -w.y));
    z[PD(pk)] = make_float2(E2.x - O2.y, E2.y + O2.x);
    if (pm != pk) z[PD(pm)] = make_float2(E2.x + O2.y, -E2.y + O2.x);
}
template <int LG, int NSEQ>
__device__ __forceinline__ void fftconv_channel(float2* z, const unsigned* spec, bf16_t* v0, int tid0) {
    constexpr int Lc = 1 << LG, NK = Lc / 1024, NL = Lc / 4096;
    unsigned sku[NK], smu[NK];
#pragma unroll
    for (int i = 0; i < NK; ++i) { const int k = tid0 + 512 * i; sku[i] = spec[k]; smu[i] = spec[(Lc - k) & (Lc - 1)]; }
    const unsigned shu = spec[Lc >> 1];
#pragma unroll 1
    for (int sq = 0; sq < NSEQ; ++sq) {
        int tid = tid0; asm volatile("" : "+v"(tid));
        bf16_t* v = v0 + (size_t)sq * Lc;
        u32x4 raw[NL];
#pragma unroll
        for (int i = 0; i < NL; ++i) raw[i] = *(const u32x4*)(v + 8 * (tid + 512 * i));
        __syncthreads();
#pragma unroll
        for (int i = 0; i < NL; ++i) {
            const int pi = PD(4 * (tid + 512 * i));
            z[pi] = make_float2(bflo(raw[i].x), bfhi(raw[i].x)); z[pi + 1] = make_float2(bflo(raw[i].y), bfhi(raw[i].y));
            z[pi + 2] = make_float2(bflo(raw[i].z), bfhi(raw[i].z)); z[pi + 3] = make_float2(bflo(raw[i].w), bfhi(raw[i].w));
        }
        for (int i = (Lc >> 1) + tid; i < Lc; i += 512) z[PD(i)] = make_float2(0.f, 0.f);
        int lgv = LG; asm volatile("" : "+s"(lgv));
        __syncthreads();
        fft_fwd(z, lgv, tid);
#pragma unroll
        for (int i = 0; i < NK; ++i) {
            int tz = 0; asm volatile("" : "+v"(tz));
            const int k = tid + tz + 512 * i;
            if (k == 0) { const float2 Z0 = z[0], K0 = make_float2(bflo(sku[0]), bfhi(sku[0])); const float Y0 = (Z0.x + Z0.y) * K0.x, YL = (Z0.x - Z0.y) * K0.y; z[0] = make_float2(0.5f * (Y0 + YL), 0.5f * (Y0 - YL)); }
            else pair_one<LG>(z, k, make_float2(bflo(sku[i]), bfhi(sku[i])), make_float2(bflo(smu[i]), bfhi(smu[i])));
        }
        if (tid == 0) pair_one<LG>(z, Lc >> 1, make_float2(bflo(shu), bfhi(shu)), make_float2(bflo(shu), bfhi(shu)));
        __syncthreads();
        fft_inv(z, lgv, tid);
#pragma unroll
        for (int i = 0; i < NL; ++i) {
            const int pi = PD(4 * (tid + 512 * i)); const float2 a = z[pi], b = z[pi + 1], cc = z[pi + 2], d = z[pi + 3];
            u32x4 o; o.x = pk2(a.x, a.y); o.y = pk2(b.x, b.y); o.z = pk2(cc.x, cc.y); o.w = pk2(d.x, d.y);
            *(u32x4*)(v + 8 * (tid + 512 * i)) = o;
        }
    }
}
__device__ __forceinline__ void ph_fftconv(KP p, unsigned char* sm, int wv) {
    float2* z = (float2*)sm;
    const int tid0 = otid(wv);
    for (int c = obid(); c < 512; c += ogrid()) {
        int tid = tid0; asm volatile("" : "+v"(tid));
        fftconv_channel<14, 1>(z, (const unsigned*)p->X + (size_t)c * 16384, p->V + (size_t)c * T, tid);
        asm volatile("" : "+v"(tid));
        fftconv_channel<13, 4>(z, (const unsigned*)p->X + 8388608 + (size_t)c * 8192, p->V + (size_t)c * T + LP, tid);
    }
}

__device__ __forceinline__ void ph_mixfinal(KP p, int l, unsigned char* sm, int wv) {
    constexpr int ZS = 257;
    bf16_t* yt = (bf16_t*)sm;
    unsigned* zt = (unsigned*)(sm + 73728);
    float* part = (float*)(sm + 73728 + 66 * ZS * 4);
    float* cw = part + 512;
    const bf16_t* Z = p->ZA;
    const int tid = otid(wv), wid = tid >> 6, lane = tid & 63, tt = lane, cg = wid;
    const float* ws = p->w_short + (size_t)l * 3 * 1536; const float* bs = p->b_short + l * 1536;
    const float* gh = p->nho + l * 512;
    __syncthreads();
    cw[tid] = ws[tid]; cw[512 + tid] = ws[1536 + tid]; cw[1024 + tid] = ws[3072 + tid]; cw[1536 + tid] = bs[tid];
    for (int tile = obid(); tile < 768; tile += ogrid()) {
        const int t0 = tile * 64; int sbase, L; seq_of(t0, sbase, L);
        const int tend = sbase + L;
        u32x4 arow[8];
#pragma unroll
        for (int i = 0; i < 8; ++i) arow[i] = *(const u32x4*)(p->Y + (size_t)(t0 + wid * 8 + i) * DM + lane * 8);
        __syncthreads();
#pragma unroll
        for (int i = 0; i < 8; ++i) {
            const int q = tid + 512 * i, cc = q >> 3, pt = q & 7;
            *(u32x4*)(yt + cc * 72 + pt * 8) = *(const u32x4*)(p->V + (size_t)cc * T + t0 + pt * 8);
        }
        for (int q = tid; q < 66 * 64; q += 512) {
            const int r = q >> 6, ch = q & 63, t = t0 - 1 + r;
            u32x4 v = (u32x4){0u, 0u, 0u, 0u};
            if (t >= sbase && t < tend) v = *(const u32x4*)(Z + (size_t)t * DIN + 768 + ch * 8);
            unsigned* d = zt + r * ZS + ch * 4;
            d[0] = v.x; d[1] = v.y; d[2] = v.z; d[3] = v.w;
        }
        __syncthreads();
        unsigned hyp[32]; float sq = 0.f;
#pragma unroll
        for (int i = 0; i < 32; ++i) {
            const int c = cg * 64 + 2 * i;
            const unsigned z_p = zt[tt * ZS + (c >> 1)], z_c = zt[(tt + 1) * ZS + (c >> 1)], z_n = zt[(tt + 2) * ZS + (c >> 1)];
            const float x0a = cw[c] * bflo(z_p) + cw[512 + c] * bflo(z_c) + cw[1024 + c] * bflo(z_n) + cw[1536 + c];
            const float x0b = cw[c + 1] * bfhi(z_p) + cw[513 + c] * bfhi(z_c) + cw[1025 + c] * bfhi(z_n) + cw[1537 + c];
            const float ha = x0a * bf1(yt[c * 72 + tt]), hb = x0b * bf1(yt[(c + 1) * 72 + tt]);
            sq += ha * ha + hb * hb;
            hyp[i] = pk2(ha, hb);
        }
        part[tt * 8 + cg] = sq;
        __syncthreads();
        {
            const f32x4 q0 = *(const f32x4*)(part + tt * 8), q1 = *(const f32x4*)(part + tt * 8 + 4);
            const float sm_ = ((q0.x + q0.y) + (q0.z + q0.w)) + ((q1.x + q1.y) + (q1.z + q1.w));
            const float r = rsqrtf(sm_ * (1.0f / 512.0f) + EPS);
            bf16_t* dst = p->Y + (size_t)(t0 + tt) * DM + 512 + cg * 64;
#pragma unroll
            for (int i8 = 0; i8 < 8; ++i8) {
                const f32x4 g0 = *(const f32x4*)(gh + cg * 64 + i8 * 8), g1 = *(const f32x4*)(gh + cg * 64 + i8 * 8 + 4);
                u32x4 o;
                o.x = pk2(bflo(hyp[i8 * 4]) * r * g0.x, bfhi(hyp[i8 * 4]) * r * g0.y); o.y = pk2(bflo(hyp[i8 * 4 + 1]) * r * g0.z, bfhi(hyp[i8 * 4 + 1]) * r * g0.w);
                o.z = pk2(bflo(hyp[i8 * 4 + 2]) * r * g1.x, bfhi(hyp[i8 * 4 + 2]) * r * g1.y); o.w = pk2(bflo(hyp[i8 * 4 + 3]) * r * g1.z, bfhi(hyp[i8 * 4 + 3]) * r * g1.w);
                *(u32x4*)(dst + i8 * 8) = o;
            }
        }
        const f32x4 ga0 = *(const f32x4*)(p->nao + l * 512 + lane * 8), ga1 = *(const f32x4*)(p->nao + l * 512 + lane * 8 + 4);
#pragma unroll
        for (int i = 0; i < 8; ++i) {
            const int t = t0 + wid * 8 + i;
            bf16_t* rowp = p->Y + (size_t)t * DM + lane * 8;
            const u32x4 raw = arow[i];
            float x[8] = {bflo(raw.x), bfhi(raw.x), bflo(raw.y), bfhi(raw.y), bflo(raw.z), bfhi(raw.z), bflo(raw.w), bfhi(raw.w)};
            float s = 0.f;
#pragma unroll
            for (int k = 0; k < 8; ++k) s += x[k] * x[k];
            s = wave_sum(s, lane);
            const float r = rsqrtf(s * (1.0f / 512.0f) + EPS);
            u32x4 o; o.x = pk2(x[0] * r * ga0.x, x[1] * r * ga0.y); o.y = pk2(x[2] * r * ga0.z, x[3] * r * ga0.w); o.z = pk2(x[4] * r * ga1.x, x[5] * r * ga1.y); o.w = pk2(x[6] * r * ga1.z, x[7] * r * ga1.w);
            *(u32x4*)rowp = o;
        }
    }
}

enum { OP_XCONV = 0, OP_WCONV, OP_GEMM_IN, OP_FILTERGEN, OP_ATTN, OP_HPRE, OP_FFFT, OP_FFTCONV, OP_MIXFINAL, OP_GEMM_OUT, OP_PCONV, OP_GEMM_UP, OP_GEMM_DOWN, OP_GEMM_GATE, OP_GEMM_PROJ };
__global__ void __launch_bounds__(512, 2) mega(P p_arg) {
    extern __shared__ __attribute__((aligned(16))) unsigned char smem[];
    LAS unsigned char* lds = (LAS unsigned char*)smem;
    const int nseq = p_arg.nseq;
    const int wv = __builtin_amdgcn_readfirstlane((int)(threadIdx.x >> 6));
    for (int si = 0; si < nseq; ++si) {
        KP p = (KP)__builtin_amdgcn_kernarg_segment_ptr();
        asm volatile("" : "+s"(p));
        const int code = __builtin_amdgcn_readfirstlane(p->seq[si]), op = code & 31, l = (code >> 5) & 3;
        const bf16_t* Wl = p->W + (size_t)(l & 1) * W_LAYER;
        if (op == OP_XCONV) ph_xconv(p, wv);
        else if (op == OP_WCONV) ph_wconv(p, l, smem, wv);
        else if (op == OP_GEMM_IN) { Sched S; S.init(192, 9, 0); EpiIn E{p->ZA, p->ss_in}; gemm_phase(lds, l == 0 ? (const bf16_t*)p->Y : (const bf16_t*)p->out, Wl + WO_IN, 1024, S, E, wv); }
        else if (op == OP_FILTERGEN) ph_filtergen(p, l, smem, wv);
        else if (op == OP_ATTN) ph_attn(p, l, smem, wv);
        else if (op == OP_HPRE) ph_hyena_pre(p, l, smem, wv);
        else if (op == OP_FFFT) ph_filter_fft(p, smem, wv);
        else if (op == OP_FFTCONV) ph_fftconv(p, smem, wv);
        else if (op == OP_MIXFINAL) ph_mixfinal(p, l, smem, wv);
        else if (op == OP_GEMM_OUT) { Sched S; S.init(192, 4, 0); EpiRes E{p->xp, p->xs, (const bf16_t*)p->out, p->X, p->ss_ffn, l == 0 ? 0 : 1}; gemm_phase(lds, p->Y, Wl + WO_OUT, 1024, S, E, wv); }
        else if (op == OP_PCONV) ph_pconv(p, l, wv);
        else if (op == OP_GEMM_UP) { Sched S; S.init(197, 22, 1); EpiUp E{p->ZA, p->ss_ffn, p->w_ffconv + (size_t)l * 3 * 5632, p->b_ffconv + (size_t)l * 5632}; gemm_phase(lds, p->X, Wl + WO_UP, 1024, S, E, wv); }
        else if (op == OP_GEMM_DOWN) { Sched S; S.init(192, 4, 0); EpiRes E{p->xp, p->xs, p->X, p->X, nullptr, 1}; gemm_phase(lds, p->ZA, Wl + WO_DOWN, 2816, S, E, wv); }
        else if (op == OP_GEMM_GATE) { Sched S; S.init(192, 4, 0); EpiGate E{p->ZA}; gemm_phase(lds, p->X, Wl + WO_GATE, 1024, S, E, wv); }
        else { Sched S; S.init(192, 4, 0); EpiProj E{p->ZA, p->X, p->out, (bf16_t*)p->out, p->ss_in, l == NLAYER - 1 ? 1 : 0}; gemm_phase(lds, p->V, Wl + WO_PROJ, 256, S, E, wv); }
        if (code & 128) { if (si + 1 < nseq) cg::this_grid().sync(); }
        else __syncthreads();
    }
}

extern "C" void kernel_launch(void* const* d_in, const int* in_sizes, int n_in, void* d_out, int out_size, void* d_ws, size_t ws_size, hipStream_t stream) {
    static int grid = 0;
    if (grid == 0) {
        if (n_in != 29 || out_size != T * DM || ws_size < WS_END) { fprintf(stderr, "kernel_launch: unexpected shapes (n_in %d out %d ws %zu need %zu)\n", n_in, out_size, ws_size, (size_t)WS_END); grid = -1; return; }
        int dev = 0, cus = 0, per_cu = 0;
        hipGetDevice(&dev);
        hipDeviceGetAttribute(&cus, hipDeviceAttributeMultiprocessorCount, dev);
        if (hipFuncSetAttribute((const void*)mega, hipFuncAttributeMaxDynamicSharedMemorySize, LDS_BYTES) != hipSuccess) { fprintf(stderr, "kernel_launch: hipFuncSetAttribute failed\n"); grid = -1; return; }
        if (hipOccupancyMaxActiveBlocksPerMultiprocessor(&per_cu, (const void*)mega, 512, LDS_BYTES) != hipSuccess || per_cu < 1) per_cu = 1;
        (void)hipGetLastError();
        grid = cus * per_cu;
    }
    if (grid < 0) return;
    P p{};
    const float** f = (const float**)&p;
    for (int i = 0; i < 29; ++i) f[i] = (const float*)d_in[i];
    p.out = (float*)d_out;
    unsigned char* ws = (unsigned char*)d_ws;
    p.X = (bf16_t*)(ws + OFF_X); p.Y = (bf16_t*)(ws + OFF_Y); p.ZA = (bf16_t*)(ws + OFF_ZA); p.V = (bf16_t*)(ws + OFF_V); p.W = (bf16_t*)(ws + OFF_W);
    p.ss_in = (float*)(ws + OFF_SSI); p.ss_ffn = (float*)(ws + OFF_SSF);
    int ns = 0;
#define EMIT(op, l, sync) p.seq[ns++] = ((op) | ((l) << 5) | ((sync) ? 128 : 0))
    EMIT(OP_XCONV, 0, 0); EMIT(OP_WCONV, 0, 1);
    for (int l = 0; l < NLAYER; ++l) {
        EMIT(OP_GEMM_IN, l, 0); EMIT(OP_FILTERGEN, l, 1);
        EMIT(OP_ATTN, l, 0); EMIT(OP_HPRE, l, 0);
        if (l + 1 < NLAYER) { EMIT(OP_FFFT, l, 0); EMIT(OP_WCONV, l + 1, 1); } else EMIT(OP_FFFT, l, 1);
#if PROBE_MASK & 1
        EMIT(OP_ATTN, l, 1);
#endif
#if PROBE_MASK & 2
        EMIT(OP_HPRE, l, 1);
#endif
#if PROBE_MASK & 4
        EMIT(OP_FILTERGEN, l, 1); EMIT(OP_FFFT, l, 1);
#endif
#if PROBE_MASK & 8
        if (l + 1 < NLAYER) EMIT(OP_WCONV, l + 1, 1);
#endif
        EMIT(OP_FFTCONV, l, 1);
#if PROBE_MASK & 16
        EMIT(OP_HPRE, l, 1); EMIT(OP_FFTCONV, l, 1);
#endif
        EMIT(OP_MIXFINAL, l, 1);
#if PROBE_MASK & 32
        EMIT(OP_ATTN, l, 1); EMIT(OP_MIXFINAL, l, 1);
#endif
        EMIT(OP_GEMM_OUT, l, 0); EMIT(OP_PCONV, l, 1);
#if PROBE_MASK & 128
        for (int r = 0; r < 4; ++r) EMIT(OP_PCONV, l, 1);
#endif
        EMIT(OP_GEMM_UP, l, 1);
#if PROBE_MASK & 64
        EMIT(OP_GEMM_UP, l, 1);
#endif
        EMIT(OP_GEMM_DOWN, l, 1);
        EMIT(OP_GEMM_GATE, l, 0);
        EMIT(OP_GEMM_PROJ, l, 1);
    }
#undef EMIT
    p.nseq = ns;
    void* args[] = {&p};
    hipError_t e = hipLaunchCooperativeKernel((const void*)mega, dim3(grid), dim3(512), args, LDS_BYTES, stream);
    if (e != hipSuccess) fprintf(stderr, "cooperative launch failed: %s (grid %d)\n", hipGetErrorString(e), grid);
}
```

```cpp
#include <hip/hip_runtime.h>
#include <hip/hip_cooperative_groups.h>
#include <cstdio>
#include <cstdint>
namespace cg = cooperative_groups;

#ifndef PROBE_MASK
#define PROBE_MASK 0
#endif

#define LAS __attribute__((address_space(3)))
typedef unsigned short bf16_t;
typedef short bf16x8 __attribute__((ext_vector_type(8)));
typedef float f32x4 __attribute__((ext_vector_type(4)));
typedef unsigned u32x4 __attribute__((ext_vector_type(4)));
typedef unsigned u32x2 __attribute__((ext_vector_type(2)));

constexpr int T = 49152, LP = 16384, LSQ = 8192, DM = 1024, DIN = 2304, DFF = 2816, NLAYER = 4;
constexpr float EPS = 1e-6f;
constexpr int LDS_BYTES = 159744;
constexpr int NPHASE = 1 + 9 * NLAYER;

constexpr size_t GUARD = 256 * 2048;
constexpr size_t SZ_HB = (size_t)T * DM * 2;
constexpr size_t OFF_X = GUARD;
constexpr size_t OFF_Y = OFF_X + SZ_HB + GUARD;
constexpr size_t OFF_ZA = OFF_Y + SZ_HB + GUARD;
constexpr size_t SZ_ZA = (size_t)T * DFF * 2;
constexpr size_t OFF_V = OFF_ZA + SZ_ZA;
constexpr size_t SZ_V = (size_t)T * 512 * 2;
constexpr size_t OFF_W = OFF_V + SZ_V;
constexpr size_t W_LAYER = 13369344;
constexpr size_t SZ_W = 2 * W_LAYER * 2;
constexpr size_t OFF_SSI = OFF_W + SZ_W;
constexpr size_t SZ_SS = (size_t)T * 16 * 4;
constexpr size_t OFF_SSF = OFF_SSI + SZ_SS;
constexpr size_t WS_END = OFF_SSF + SZ_SS;
constexpr size_t WO_IN = 0, WO_OUT = 2359296, WO_UP = 3407872, WO_DOWN = 9175040, WO_GATE = 12058624, WO_PROJ = 13107200;

struct P {
    const float *xp, *xs, *pp, *ps;
    const float *rms_mix, *w_in, *q_norm, *k_norm, *sink, *w_short, *b_short, *fw1, *fb1, *ffr1, *fw2, *fb2, *ffr2, *fw3, *hbias, *nao, *nho, *w_out, *rms_ffn, *w_up, *w_ffconv, *b_ffconv, *w_down, *w_gate, *w_proj;
    float* out;
    bf16_t *X, *Y, *ZA, *V, *W;
    float *ss_in, *ss_ffn;
    int nseq; int seq[125];
};

typedef const __attribute__((address_space(4))) P* KP;

__device__ __forceinline__ unsigned pk2(float lo, float hi) { unsigned r; asm volatile("v_cvt_pk_bf16_f32 %0, %1, %2" : "=v"(r) : "v"(lo), "v"(hi)); return r; }
__device__ __forceinline__ float bflo(unsigned u) { return __uint_as_float(u << 16); }
__device__ __forceinline__ float bfhi(unsigned u) { return __uint_as_float(u & 0xffff0000u); }
__device__ __forceinline__ float2 twid(float turns) { return make_float2(__builtin_amdgcn_cosf(turns), __builtin_amdgcn_sinf(turns)); }
__device__ __forceinline__ float2 twid_precise(float turns) { float s_, c_; sincospif(2.0f * turns, &s_, &c_); return make_float2(c_, s_); }
__device__ __forceinline__ float frcp(float x) { return 1.0f / x; }
__device__ __forceinline__ float rcp_nr(float x) { const float y = __builtin_amdgcn_rcpf(x); return __builtin_fmaf(y, __builtin_fmaf(-x, y, 1.0f), y); }
__device__ __forceinline__ float bf1(bf16_t h) { return __uint_as_float(((unsigned)h) << 16); }
__device__ __forceinline__ int otid(int wv) { unsigned z = 0; asm volatile("" : "+v"(z)); int t = wv * 64 + (int)__builtin_amdgcn_mbcnt_hi(~0u, __builtin_amdgcn_mbcnt_lo(~0u, z)); asm volatile("" : "+v"(t)); return t; }
__device__ __forceinline__ int obid() { int b = blockIdx.x; asm volatile("" : "+s"(b)); return b; }
__device__ __forceinline__ int ogrid() { int g = gridDim.x; asm volatile("" : "+s"(g)); return g; }
__device__ __forceinline__ float shx(float v, int mask, int lane) { return __int_as_float(__builtin_amdgcn_ds_bpermute((lane ^ mask) << 2, __float_as_int(v))); }
__device__ __forceinline__ float wave_sum(float v, int lane) {
#pragma unroll
    for (int o = 32; o >= 1; o >>= 1) v += shx(v, o, lane);
    return v;
}
__device__ __forceinline__ void seq_of(int t, int& sbase, int& L) {
    if (t < LP) { sbase = 0; L = LP; } else { sbase = LP + ((t - LP) / LSQ) * LSQ; L = LSQ; }
}

__device__ __forceinline__ void ph_xconv(KP p, int wv) {
    const int tid0 = otid(wv), wid = tid0 >> 6, lane = tid0 & 63;
    for (int t = obid() * 8 + wid; t < T; t += ogrid() * 8) {
        const float* src = t < LP ? p->xp + (size_t)t * DM : p->xs + (size_t)(t - LP) * DM;
        float ss = 0.f;
#pragma unroll
        for (int i = 0; i < 4; ++i) {
            f32x4 v = *(const f32x4*)(src + i * 256 + lane * 4);
            ss += v.x * v.x + v.y * v.y + v.z * v.z + v.w * v.w;
            u32x2 o; o.x = pk2(v.x, v.y); o.y = pk2(v.z, v.w);
            *(u32x2*)(p->Y + (size_t)t * DM + i * 256 + lane * 4) = o;
        }
        ss = wave_sum(ss, lane);
        if (lane < 16) p->ss_in[(size_t)t * 16 + lane] = lane == 0 ? ss : 0.f;
    }
}

__device__ __forceinline__ void ph_wconv(KP p, int l, unsigned char* sm, int wv) {
    float* tl = (float*)sm;
    bf16_t* Wl = p->W + (size_t)(l & 1) * W_LAYER;
    const int tid = otid(wv);
    for (int g = obid(); g < 3264; g += ogrid()) {
        const float* src; const float* gain = nullptr; bf16_t* dst; int K, N, tile;
        if (g < 576) { src = p->w_in + (size_t)l * 1024 * 2304; gain = p->rms_mix + l * 1024; dst = Wl + WO_IN; K = 1024; N = 2304; tile = g; }
        else if (g < 832) { src = p->w_out + (size_t)l * 1024 * 1024; dst = Wl + WO_OUT; K = 1024; N = 1024; tile = g - 576; }
        else if (g < 2240) { src = p->w_up + (size_t)l * 1024 * 5632; gain = p->rms_ffn + l * 1024; dst = Wl + WO_UP; K = 1024; N = 5632; tile = g - 832; }
        else if (g < 2944) { src = p->w_down + (size_t)l * 2816 * 1024; dst = Wl + WO_DOWN; K = 2816; N = 1024; tile = g - 2240; }
        else if (g < 3200) { src = p->w_gate + (size_t)l * 1024 * 1024; dst = Wl + WO_GATE; K = 1024; N = 1024; tile = g - 2944; }
        else { src = p->w_proj + (size_t)l * 256 * 1024; dst = Wl + WO_PROJ; K = 256; N = 1024; tile = g - 3200; }
        const int ntn = N / 64, k0 = (tile / ntn) * 64, n0 = (tile % ntn) * 64;
        __syncthreads();
#pragma unroll
        for (int i = 0; i < 8; ++i) {
            const int r = (tid >> 6) + 8 * i, c = tid & 63;
            float v = src[(size_t)(k0 + r) * N + n0 + c];
            if (gain) v *= gain[k0 + r];
            tl[r * 65 + c] = v;
        }
        __syncthreads();
#pragma unroll
        for (int i = 0; i < 8; ++i) {
            const int r = (tid >> 6) + 8 * i, c = tid & 63;
            unsigned pk = pk2(tl[c * 65 + r], 0.f);
            dst[(size_t)(n0 + r) * K + k0 + c] = (bf16_t)(pk & 0xffffu);
        }
    }
}

__device__ __forceinline__ void ph_pconv(KP p, int l, int wv) {
    for (int i = obid() * 512 + otid(wv); i < T * 32; i += ogrid() * 512) {
        const int t = i >> 5, c8 = (i & 31) * 8;
        const float* src = t < LP ? p->pp + ((size_t)l * LP + t) * 256 + c8 : p->ps + ((size_t)l * 32768 + (t - LP)) * 256 + c8;
        f32x4 a = *(const f32x4*)src, b = *(const f32x4*)(src + 4);
        u32x4 o; o.x = pk2(a.x, a.y); o.y = pk2(a.z, a.w); o.z = pk2(b.x, b.y); o.w = pk2(b.z, b.w);
        *(u32x4*)(p->V + (size_t)t * 256 + c8) = o;
    }
}

constexpr int BM = 256, BK = 64, HALF = 128, HTB = HALF * BK * 2, NXCD = 8, WGM = 4;
__device__ __forceinline__ int lds_byte(int r, int c) { const int st = (r >> 4) * 2 + (c >> 5), rr = r & 15, cc = c & 31, ob = rr * 64 + cc * 2; return st * 1024 + (ob ^ (((ob >> 9) & 1) << 5)); }
__device__ __forceinline__ void stage_rc(int b, int& R, int& C) { const int st = b / 1024, sb = b % 1024, swz = sb ^ (((sb >> 9) & 1) << 5); R = (st >> 1) * 16 + swz / 64; C = (st & 1) * 32 + (swz % 64) / 2; }
__device__ __forceinline__ int perm32(int rho) { const int n = rho >> 4, i = rho & 15; return 8 * (i >> 2) + 4 * n + (i & 3); }

struct Unit { int pm, pn; long arow; int b0, b1; };
struct Sched {
    int nM, nN, nwg, G, c, mode;
    __device__ __forceinline__ void init(int nM_, int nN_, int mode_) { nM = nM_; nN = nN_; nwg = nM * nN; G = ogrid(); c = obid(); mode = mode_; }
    __device__ __forceinline__ bool next(int i, Unit& u) const {
        const long Lx = (long)i * G + c; if (Lx >= nwg) return false;
        int wgid = (int)Lx; { const int q = nwg / NXCD, r = nwg % NXCD, xcd = wgid % NXCD, off = wgid / NXCD; wgid = (xcd < r ? xcd * (q + 1) : r * (q + 1) + (xcd - r) * q) + off; }
        const int nig = WGM * nN, gid = wgid / nig, fm = gid * WGM, gsz = (nM - fm) < WGM ? (nM - fm) : WGM;
        u.pm = fm + ((wgid % nig) % gsz); u.pn = (wgid % nig) / gsz;
        if (mode == 0) { u.arow = (long)u.pm * 256; u.b0 = u.pn * 256; u.b1 = u.pn * 256 + 128; }
        else {
            int sb, i2; if (u.pm < 65) { sb = 0; i2 = u.pm; } else { const int r = u.pm - 65; sb = LP + (r / 33) * LSQ; i2 = r % 33; }
            u.arow = (long)sb + 254 * i2 - 1; u.b0 = u.pn * 128; u.b1 = DFF + u.pn * 128;
        }
        return true;
    }
};

template <class Epi>
__device__ __forceinline__ void gemm_phase(LAS unsigned char* lds, const bf16_t* Ag, const bf16_t* Btg, const int K, const Sched& S, const Epi& E, int wv) {
    const int tid = otid(wv), wid = __builtin_amdgcn_readfirstlane(tid >> 6), lane = tid & 63, wr = wid >> 2, wc = wid & 3, fr = lane & 15, fq = lane >> 4;
    const int nt = K / BK;
    unsigned voffA[2], voffB[2];
#pragma unroll
    for (int i = 0; i < 2; ++i) { int R, C; stage_rc(tid * 16 + i * 8192, R, C); const int Rb = (R & ~31) + perm32(R & 31);
        voffA[i] = (unsigned)(R * K + C) * 2u; voffB[i] = (unsigned)(Rb * K + C) * 2u; }
    const size_t kstep = (size_t)(BK * 2);
    const size_t hstep = (size_t)HALF * K * 2;
    const size_t rowb = (size_t)K * 2;
    const unsigned ldsw = (unsigned)wid * 1024u;
    const int aoff = lds_byte(wr * 64 + fr, fq * 8), boff = lds_byte(wc * 32 + fr, fq * 8);
#define G_SA(b, h) (((b) * 2 + (h)) * HTB)
#define G_SB(b, h) ((4 + (b) * 2 + (h)) * HTB)
#define G_STAGE(bufoff, gbase, voff) do { const char* _gb = (const char*)(gbase); asm volatile("" : "+s"(_gb)); _Pragma("unroll") for (int _i = 0; _i < 2; ++_i) \
        __builtin_amdgcn_global_load_lds((const unsigned*)(_gb + (voff)[_i]), (LAS unsigned*)(lds + (bufoff) + ldsw + _i * 8192), 16, 0, 0); } while (0)
#define G_LDA(dst, b, h) do { _Pragma("unroll") for (int m = 0; m < 4; ++m) _Pragma("unroll") for (int k = 0; k < 2; ++k) dst[m][k] = *(const LAS bf16x8*)(lds + G_SA(b, h) + aoff + m * 2048 + k * 1024); } while (0)
#define G_LDB(dst, b, h) do { _Pragma("unroll") for (int n = 0; n < 2; ++n) _Pragma("unroll") for (int k = 0; k < 2; ++k) dst[n][k] = *(const LAS bf16x8*)(lds + G_SB(b, h) + boff + n * 2048 + k * 1024); } while (0)
#define G_MMA(ai, bj, At, Bt) do { __builtin_amdgcn_s_setprio(1); _Pragma("unroll") for (int m = 0; m < 4; ++m) _Pragma("unroll") for (int n = 0; n < 2; ++n) _Pragma("unroll") for (int k = 0; k < 2; ++k) \
        acc[ai][bj][m][n] = __builtin_amdgcn_mfma_f32_16x16x32_bf16(Bt[n][k], At[m][k], acc[ai][bj][m][n], 0, 0, 0); __builtin_amdgcn_s_setprio(0); } while (0)
#define G_WAIT_V(n) asm volatile("s_waitcnt vmcnt(" #n ")" ::: "memory")
#define G_WAIT_L(n) asm volatile("s_waitcnt lgkmcnt(" #n ")" ::: "memory")
#define G_BAR __builtin_amdgcn_s_barrier()
#define G_SCHED __builtin_amdgcn_sched_barrier(0)
    Unit cur, nxt; int ui = 0;
    if (!S.next(0, cur)) return;
    f32x4 acc[2][2][4][2];
#pragma unroll
    for (int a = 0; a < 2; ++a)
#pragma unroll
        for (int b = 0; b < 2; ++b)
#pragma unroll
            for (int m = 0; m < 4; ++m)
#pragma unroll
                for (int n = 0; n < 2; ++n) acc[a][b][m][n] = (f32x4){0.f, 0.f, 0.f, 0.f};
    bf16x8 At[4][2], B0[2][2], B1[2][2];
    const char* cA = (const char*)Ag + cur.arow * (long)rowb;
    const char* cB0 = (const char*)Btg + (size_t)cur.b0 * rowb;
    const char* cB1 = (const char*)Btg + (size_t)cur.b1 * rowb;
    G_STAGE(G_SB(0, 0), cB0, voffB); G_STAGE(G_SA(0, 0), cA, voffA); G_STAGE(G_SB(0, 1), cB1, voffB); G_STAGE(G_SA(0, 1), cA + hstep, voffA);
    if (wr == 1) G_BAR;
    G_WAIT_V(4); G_BAR;
    G_STAGE(G_SB(1, 0), cB0 + kstep, voffB); G_STAGE(G_SA(1, 0), cA + kstep, voffA); G_STAGE(G_SB(1, 1), cB1 + kstep, voffB);
    G_WAIT_V(6); G_BAR;
    for (;;) {
        const bool has_next = S.next(ui + 1, nxt);
        const char* nA = has_next ? (const char*)Ag + nxt.arow * (long)rowb : cA;
        const char* nB0 = has_next ? (const char*)Btg + (size_t)nxt.b0 * rowb : cB0;
        const char* nB1 = has_next ? (const char*)Btg + (size_t)nxt.b1 * rowb : cB1;
        for (int t = 0; t < nt; t += 2) {
            const bool last = (t == nt - 2);
            const char* a1 = cA + (size_t)(t + 1) * kstep;
            const char* a2 = last ? nA : cA + (size_t)(t + 2) * kstep;
            const char* b20 = last ? nB0 : cB0 + (size_t)(t + 2) * kstep;
            const char* b21 = last ? nB1 : cB1 + (size_t)(t + 2) * kstep;
            const char* a3 = a2 + kstep; const char* b30 = b20 + kstep; const char* b31 = b21 + kstep;
            G_LDB(B0, 0, 0); G_SCHED; G_LDA(At, 0, 0); G_STAGE(G_SA(1, 1), a1 + hstep, voffA);
            G_WAIT_L(8); G_BAR; G_WAIT_L(0); G_MMA(0, 0, At, B0); G_BAR; G_SCHED;
            G_LDB(B1, 0, 1); G_STAGE(G_SB(0, 0), b20, voffB);
            G_BAR; G_WAIT_L(0); G_MMA(0, 1, At, B1); G_BAR;
            G_LDA(At, 0, 1); G_STAGE(G_SA(0, 0), a2, voffA);
            G_BAR; G_WAIT_L(0); G_MMA(1, 0, At, B0); G_BAR; G_SCHED;
            G_STAGE(G_SB(0, 1), b21, voffB);
            G_WAIT_V(6); G_BAR; G_MMA(1, 1, At, B1); G_BAR;
            G_LDB(B0, 1, 0); G_SCHED; G_LDA(At, 1, 0); G_STAGE(G_SA(0, 1), a2 + hstep, voffA);
            G_WAIT_L(8); G_BAR; G_WAIT_L(0); G_MMA(0, 0, At, B0); G_BAR; G_SCHED;
            G_LDB(B1, 1, 1); G_STAGE(G_SB(1, 0), b30, voffB);
            G_BAR; G_WAIT_L(0); G_MMA(0, 1, At, B1); G_BAR;
            G_LDA(At, 1, 1); G_STAGE(G_SA(1, 0), a3, voffA);
            G_BAR; G_WAIT_L(0); G_MMA(1, 0, At, B0); G_BAR; G_SCHED;
            G_STAGE(G_SB(1, 1), b31, voffB);
            G_WAIT_V(6); G_BAR; G_MMA(1, 1, At, B1); G_BAR;
        }
        E(acc, cur, wr, wc, fr, fq, lds);
        if (!has_next) break;
#pragma unroll
        for (int a = 0; a < 2; ++a)
#pragma unroll
            for (int b = 0; b < 2; ++b)
#pragma unroll
                for (int m = 0; m < 4; ++m)
#pragma unroll
                    for (int n = 0; n < 2; ++n) acc[a][b][m][n] = (f32x4){0.f, 0.f, 0.f, 0.f};
        cur = nxt; cA = nA; cB0 = nB0; cB1 = nB1; ++ui;
    }
    G_WAIT_V(0);
    if (wr == 0) G_BAR;
    G_BAR;
#undef G_SA
#undef G_SB
#undef G_STAGE
#undef G_LDA
#undef G_LDB
#undef G_MMA
}

constexpr int EPI_XB = 131072, EPI_RS = 131072 + 4096, EPI_CW = 131072 + 5120;
__device__ __forceinline__ void stage_rstd(LAS unsigned char* lds, const float* ss, int tid, long grow0, int sr0, int L) {
    if (tid < 256) {
        const int sr = sr0 + tid; const bool valid = sr >= 0 && sr < L;
        const f32x4* q = (const f32x4*)(ss + (size_t)(valid ? grow0 + tid : 0) * 16);
        const f32x4 a = q[0], b = q[1], c = q[2], d = q[3];
        const float sm_ = ((a.x + a.y) + (a.z + a.w)) + ((b.x + b.y) + (b.z + b.w)) + ((c.x + c.y) + (c.z + c.w)) + ((d.x + d.y) + (d.z + d.w));
        ((LAS float*)(lds + EPI_RS))[tid] = valid ? rsqrtf(sm_ * (1.0f / 1024.0f) + EPS) : 0.f;
    }
}
#define EPI_SYNC() do { asm volatile("s_waitcnt lgkmcnt(0)" ::: "memory"); __builtin_amdgcn_s_barrier(); __builtin_amdgcn_s_barrier(); asm volatile("" ::: "memory"); } while (0)

struct EpiIn {
    bf16_t* Z; const float* ss;
    __device__ __forceinline__ void operator()(f32x4 (&acc)[2][2][4][2], const Unit& u, int wr, int wc, int fr, int fq, LAS unsigned char* lds) const {
        asm volatile("" : "+v"(fr), "+v"(fq), "+s"(wr), "+s"(wc));
        const int tid = (wr * 4 + wc) * 64 + fq * 16 + fr;
        stage_rstd(lds, ss, tid, (long)u.pm * 256, 0, 1 << 30);
        EPI_SYNC();
        const LAS float* rs = (const LAS float*)(lds + EPI_RS);
        const int row0 = u.pm * 256 + wr * 64 + fr, col0 = wc * 32 + 8 * fq;
#pragma unroll
        for (int ai = 0; ai < 2; ++ai)
#pragma unroll
            for (int m = 0; m < 4; ++m) {
                const int row = row0 + ai * 128 + m * 16; const float r = rs[128 * ai + 64 * wr + 16 * m + fr];
#pragma unroll
                for (int bj = 0; bj < 2; ++bj) {
                    const f32x4 v0 = acc[ai][bj][m][0] * r, v1 = acc[ai][bj][m][1] * r;
                    u32x4 o; o.x = pk2(v0.x, v0.y); o.y = pk2(v0.z, v0.w); o.z = pk2(v1.x, v1.y); o.w = pk2(v1.z, v1.w);
                    *(u32x4*)(Z + (size_t)row * DIN + (bj ? u.b1 : u.b0) + col0) = o;
                }
            }
    }
};
struct EpiRes {
    const float* xp; const float* xs; const bf16_t* rsrc; bf16_t* hb; float* ss; int mode;
    __device__ __forceinline__ void operator()(f32x4 (&acc)[2][2][4][2], const Unit& u, int wr, int wc, int fr, int fq, LAS unsigned char*) const {
        asm volatile("" : "+v"(fr), "+v"(fq), "+s"(wr), "+s"(wc));
        const int row0 = u.pm * 256 + wr * 64 + fr, col0 = wc * 32 + 8 * fq;
#pragma unroll
        for (int ai = 0; ai < 2; ++ai) {
            __builtin_amdgcn_sched_barrier(0);
            f32x4 rv[4][2][2];
            if (mode == 0) {
#pragma unroll
                for (int m = 0; m < 4; ++m) {
                    const int row = row0 + ai * 128 + m * 16;
                    const float* rp = row < LP ? xp + (size_t)row * DM : xs + (size_t)(row - LP) * DM;
#pragma unroll
                    for (int bj = 0; bj < 2; ++bj) { const int col = (bj ? u.b1 : u.b0) + col0; rv[m][bj][0] = *(const f32x4*)(rp + col); rv[m][bj][1] = *(const f32x4*)(rp + col + 4); }
                }
            } else {
                u32x4 rb[4][2];
#pragma unroll
                for (int m = 0; m < 4; ++m)
#pragma unroll
                    for (int bj = 0; bj < 2; ++bj) rb[m][bj] = *(const u32x4*)(rsrc + (size_t)(row0 + ai * 128 + m * 16) * DM + (bj ? u.b1 : u.b0) + col0);
#pragma unroll
                for (int m = 0; m < 4; ++m)
#pragma unroll
                    for (int bj = 0; bj < 2; ++bj) {
                        const u32x4 q = rb[m][bj];
                        rv[m][bj][0] = (f32x4){bflo(q.x), bfhi(q.x), bflo(q.y), bfhi(q.y)}; rv[m][bj][1] = (f32x4){bflo(q.z), bfhi(q.z), bflo(q.w), bfhi(q.w)};
                    }
            }
            __builtin_amdgcn_sched_barrier(0);
#pragma unroll
            for (int m = 0; m < 4; ++m) {
                const int row = row0 + ai * 128 + m * 16;
                float sq = 0.f;
#pragma unroll
                for (int bj = 0; bj < 2; ++bj) {
                    const int col = (bj ? u.b1 : u.b0) + col0;
                    const f32x4 h0 = rv[m][bj][0] + acc[ai][bj][m][0], h1 = rv[m][bj][1] + acc[ai][bj][m][1];
                    sq += h0.x * h0.x + h0.y * h0.y + h0.z * h0.z + h0.w * h0.w + h1.x * h1.x + h1.y * h1.y + h1.z * h1.z + h1.w * h1.w;
                    u32x4 o; o.x = pk2(h0.x, h0.y); o.y = pk2(h0.z, h0.w); o.z = pk2(h1.x, h1.y); o.w = pk2(h1.z, h1.w);
                    *(u32x4*)(hb + (size_t)row * DM + col) = o;
                }
                if (ss) { sq += shx(sq, 16, fq * 16 + fr); sq += shx(sq, 32, fq * 16 + fr); if (fq == 0) ss[(size_t)row * 16 + u.pn * 4 + wc] = sq; }
            }
        }
    }
};
struct EpiGate {
    bf16_t* Sg;
    __device__ __forceinline__ void operator()(f32x4 (&acc)[2][2][4][2], const Unit& u, int wr, int wc, int fr, int fq, LAS unsigned char*) const {
        asm volatile("" : "+v"(fr), "+v"(fq), "+s"(wr), "+s"(wc));
        const int row0 = u.pm * 256 + wr * 64 + fr, col0 = wc * 32 + 8 * fq;
#pragma unroll
        for (int ai = 0; ai < 2; ++ai)
#pragma unroll
            for (int m = 0; m < 4; ++m) {
                __builtin_amdgcn_sched_barrier(0); const int row = row0 + ai * 128 + m * 16;
#pragma unroll
                for (int bj = 0; bj < 2; ++bj) {
                    float s[8];
#pragma unroll
                    for (int n = 0; n < 2; ++n)
#pragma unroll
                        for (int j = 0; j < 4; ++j) s[n * 4 + j] = frcp(1.0f + __expf(-acc[ai][bj][m][n][j]));
                    u32x4 o; o.x = pk2(s[0], s[1]); o.y = pk2(s[2], s[3]); o.z = pk2(s[4], s[5]); o.w = pk2(s[6], s[7]);
                    *(u32x4*)(Sg + (size_t)row * DM + (bj ? u.b1 : u.b0) + col0) = o;
                }
            }
    }
};
struct EpiProj {
    const bf16_t* Sg; const bf16_t* hbx; float* out; bf16_t* hb; float* ss; int last;
    __device__ __forceinline__ void operator()(f32x4 (&acc)[2][2][4][2], const Unit& u, int wr, int wc, int fr, int fq, LAS unsigned char*) const {
        asm volatile("" : "+v"(fr), "+v"(fq), "+s"(wr), "+s"(wc));
        const int row0 = u.pm * 256 + wr * 64 + fr, col0 = wc * 32 + 8 * fq;
#pragma unroll
        for (int ai = 0; ai < 2; ++ai)
#pragma unroll
            for (int mp = 0; mp < 2; ++mp) {
                __builtin_amdgcn_sched_barrier(0);
                u32x4 sgv[2][2], ovb[2][2]; f32x4 ov[2][2][2];
#pragma unroll
                for (int mm = 0; mm < 2; ++mm) {
                    const int row = row0 + ai * 128 + (mp * 2 + mm) * 16;
#pragma unroll
                    for (int bj = 0; bj < 2; ++bj) {
                        const int col = (bj ? u.b1 : u.b0) + col0;
                        sgv[mm][bj] = *(const u32x4*)(Sg + (size_t)row * DM + col);
                        ovb[mm][bj] = *(const u32x4*)(hbx + (size_t)row * DM + col);
                    }
                }
                __builtin_amdgcn_sched_barrier(0);
#pragma unroll
                for (int mm = 0; mm < 2; ++mm)
#pragma unroll
                    for (int bj = 0; bj < 2; ++bj) {
                        const u32x4 q = ovb[mm][bj];
                        ov[mm][bj][0] = (f32x4){bflo(q.x), bfhi(q.x), bflo(q.y), bfhi(q.y)}; ov[mm][bj][1] = (f32x4){bflo(q.z), bfhi(q.z), bflo(q.w), bfhi(q.w)};
                    }
#pragma unroll
                for (int mm = 0; mm < 2; ++mm) {
                    const int m = mp * 2 + mm, row = row0 + ai * 128 + m * 16;
                    float sq = 0.f;
#pragma unroll
                    for (int bj = 0; bj < 2; ++bj) {
                        const int col = (bj ? u.b1 : u.b0) + col0;
                        const u32x4 sg = sgv[mm][bj];
                        f32x4 g0, g1; g0.x = bflo(sg.x); g0.y = bfhi(sg.x); g0.z = bflo(sg.y); g0.w = bfhi(sg.y); g1.x = bflo(sg.z); g1.y = bfhi(sg.z); g1.z = bflo(sg.w); g1.w = bfhi(sg.w);
                        const f32x4 h0 = ov[mm][bj][0] + g0 * acc[ai][bj][m][0], h1 = ov[mm][bj][1] + g1 * acc[ai][bj][m][1];
                        if (last) { float* op = out + (size_t)row * DM + col; *(f32x4*)op = h0; *(f32x4*)(op + 4) = h1; }
                        sq += h0.x * h0.x + h0.y * h0.y + h0.z * h0.z + h0.w * h0.w + h1.x * h1.x + h1.y * h1.y + h1.z * h1.z + h1.w * h1.w;
                        if (!last) { u32x4 o; o.x = pk2(h0.x, h0.y); o.y = pk2(h0.z, h0.w); o.z = pk2(h1.x, h1.y); o.w = pk2(h1.z, h1.w); *(u32x4*)(hb + (size_t)row * DM + col) = o; }
                    }
                    sq += shx(sq, 16, fq * 16 + fr); sq += shx(sq, 32, fq * 16 + fr); if (fq == 0 && !last) ss[(size_t)row * 16 + u.pn * 4 + wc] = sq;
                }
            }
    }
};
__device__ __forceinline__ unsigned dppu_ror1(unsigned x) { return (unsigned)__builtin_amdgcn_update_dpp(0, (int)x, 0x121, 0xf, 0xf, false); }
__device__ __forceinline__ unsigned dppu_ror15(unsigned x) { return (unsigned)__builtin_amdgcn_update_dpp(0, (int)x, 0x12F, 0xf, 0xf, false); }
struct EpiUp {
    bf16_t* act; const float* ss; const float* w3; const float* b3;
    __device__ __forceinline__ void operator()(f32x4 (&acc)[2][2][4][2], const Unit& u, int wr, int wc, int fr, int fq, LAS unsigned char* lds) const {
        asm volatile("" : "+v"(fr), "+v"(fq), "+s"(wr), "+s"(wc));
        int sb, L, i2; if (u.pm < 65) { sb = 0; L = LP; i2 = u.pm; } else { const int r = u.pm - 65; sb = LP + (r / 33) * LSQ; L = LSQ; i2 = r % 33; }
        const int sr0 = 254 * i2 - 1;
        const int tid = (wr * 4 + wc) * 64 + fq * 16 + fr;
        stage_rstd(lds, ss, tid, (long)sb + sr0, sr0, L);
        {
            LAS float* cw = (LAS float*)(lds + EPI_CW);
#pragma unroll
            for (int i = 0; i < 2; ++i) {
                const int e = tid + 512 * i, bj = e >> 9, k = (e >> 7) & 3, c = e & 127;
                cw[e] = k < 3 ? w3[k * 2 * DFF + bj * DFF + u.b0 + c] : b3[bj * DFF + u.b0 + c];
            }
        }
        EPI_SYNC();
        const LAS float* rs = (const LAS float*)(lds + EPI_RS);
        unsigned pq[2][2][4][2][2];
#pragma unroll
        for (int ai = 0; ai < 2; ++ai)
#pragma unroll
            for (int m = 0; m < 4; ++m) {
                const float r = rs[128 * ai + 64 * wr + 16 * m + fr];
#pragma unroll
                for (int bj = 0; bj < 2; ++bj)
#pragma unroll
                    for (int n = 0; n < 2; ++n) {
                        const f32x4 v = acc[ai][bj][m][n];
                        pq[ai][bj][m][n][0] = r != 0.f ? pk2(v.x * r, v.y * r) : 0u;
                        pq[ai][bj][m][n][1] = r != 0.f ? pk2(v.z * r, v.w * r) : 0u;
                    }
            }
        LAS unsigned* xb = (LAS unsigned*)(lds + EPI_XB);
        const int clp = 16 * wc + 4 * fq;
        if (fr == 0) {
#pragma unroll
            for (int ai = 0; ai < 2; ++ai)
#pragma unroll
                for (int bj = 0; bj < 2; ++bj)
#pragma unroll
                    for (int n = 0; n < 2; ++n) { u32x2 t; t.x = pq[ai][bj][0][n][0]; t.y = pq[ai][bj][0][n][1]; *(LAS u32x2*)(xb + ((ai * 2 + wr) * 2 + 0) * 128 + 64 * bj + clp + 2 * n) = t; }
        }
        if (fr == 15) {
#pragma unroll
            for (int ai = 0; ai < 2; ++ai)
#pragma unroll
                for (int bj = 0; bj < 2; ++bj)
#pragma unroll
                    for (int n = 0; n < 2; ++n) { u32x2 t; t.x = pq[ai][bj][3][n][0]; t.y = pq[ai][bj][3][n][1]; *(LAS u32x2*)(xb + ((ai * 2 + wr) * 2 + 1) * 128 + 64 * bj + clp + 2 * n) = t; }
        }
        EPI_SYNC();
        constexpr bool r1prev = true;
        const int cl = 32 * wc + 8 * fq;
#pragma unroll
        for (int ai = 0; ai < 2; ++ai) {
            const int pa = wr ? ai : ai - 1, pw = wr ? 0 : 1, na = wr ? ai + 1 : ai, nw = wr ? 0 : 1;
            const bool hasp = pa >= 0 && fr == 0, hasn = na < 2 && fr == 15;
            unsigned outp[4][4];
#pragma unroll
            for (int n = 0; n < 2; ++n) {
                const LAS unsigned* xp_ = xb + (((pa < 0 ? 0 : pa) * 2 + pw) * 2 + 1) * 128 + clp + 2 * n;
                const LAS unsigned* xn_ = xb + (((na > 1 ? 1 : na) * 2 + nw) * 2 + 0) * 128 + clp + 2 * n;
#pragma unroll
                for (int jp = 0; jp < 2; ++jp) {
                    __builtin_amdgcn_sched_barrier(0);
                    float ag[2][4][2];
#pragma unroll
                    for (int bj = 0; bj < 2; ++bj) {
                        const LAS float* cwp = (const LAS float*)(lds + EPI_CW) + bj * 512 + cl + 4 * n + 2 * jp;
                        const float w0a = cwp[0], w0b = cwp[1], w1a = cwp[128], w1b = cwp[129], w2a = cwp[256], w2b = cwp[257], bba = cwp[384], bbb = cwp[385];
                        const unsigned hpv = hasp ? xp_[64 * bj + jp] : 0u, hnv = hasn ? xn_[64 * bj + jp] : 0u;
                        unsigned cv[4], ra[4], rb[4];
#pragma unroll
                        for (int m = 0; m < 4; ++m) { cv[m] = pq[ai][bj][m][n][jp]; const unsigned x1 = dppu_ror1(cv[m]), x15 = dppu_ror15(cv[m]); ra[m] = r1prev ? x1 : x15; rb[m] = r1prev ? x15 : x1; }
#pragma unroll
                        for (int m = 0; m < 4; ++m) {
                            const unsigned pv = fr > 0 ? ra[m] : (m > 0 ? ra[m > 0 ? m - 1 : 0] : hpv);
                            const unsigned nv = fr < 15 ? rb[m] : (m < 3 ? rb[m < 3 ? m + 1 : 3] : hnv);
                            ag[bj][m][0] = w0a * bflo(pv) + w1a * bflo(cv[m]) + w2a * bflo(nv) + bba;
                            ag[bj][m][1] = w0b * bfhi(pv) + w1b * bfhi(cv[m]) + w2b * bfhi(nv) + bbb;
                        }
                    }
#pragma unroll
                    for (int m = 0; m < 4; ++m) {
                        const float r0 = ag[0][m][0] * ag[1][m][0] * rcp_nr(1.0f + fminf(__expf(-ag[1][m][0]), 1e30f)), r1 = ag[0][m][1] * ag[1][m][1] * rcp_nr(1.0f + fminf(__expf(-ag[1][m][1]), 1e30f));
                        outp[m][2 * n + jp] = pk2(r0, r1);
                    }
                }
            }
#pragma unroll
            for (int m = 0; m < 4; ++m) {
                const int rt = 128 * ai + 64 * wr + 16 * m + fr, sr = sr0 + rt;
                if (rt >= 1 && rt <= 254 && sr < L) { u32x4 o; o.x = outp[m][0]; o.y = outp[m][1]; o.z = outp[m][2]; o.w = outp[m][3]; *(u32x4*)(act + (size_t)(sb + sr) * DFF + u.b0 + cl) = o; }
            }
        }
    }
};

__device__ __forceinline__ void unpack16(const u32x4& a, const u32x4& b, float (&x)[16]) {
    x[0] = bflo(a.x); x[1] = bfhi(a.x); x[2] = bflo(a.y); x[3] = bfhi(a.y); x[4] = bflo(a.z); x[5] = bfhi(a.z); x[6] = bflo(a.w); x[7] = bfhi(a.w);
    x[8] = bflo(b.x); x[9] = bfhi(b.x); x[10] = bflo(b.y); x[11] = bfhi(b.y); x[12] = bflo(b.z); x[13] = bfhi(b.z); x[14] = bflo(b.w); x[15] = bfhi(b.w);
}
__device__ __forceinline__ void qk_prep_store(u32x4 a, u32x4 b, const float* gain, int sub, int pos, float scale, bf16_t* dst, int lane) {
    float x[16]; unpack16(a, b, x);
    float ss = 0.f;
#pragma unroll
    for (int i = 0; i < 16; ++i) ss += x[i] * x[i];
    ss += shx(ss, 1, lane); ss += shx(ss, 2, lane);
    const float r = rsqrtf(ss * (1.0f / 64.0f) + EPS);
#pragma unroll
    for (int i = 0; i < 16; ++i) x[i] = x[i] * r * gain[sub * 16 + i];
    if (sub == 0) {
        const float ihi[8] = {(float)(1.0 / 3.14159265358979323846), (float)(0.19392274474868576 / 3.14159265358979323846), (float)(0.03760603093086393 / 3.14159265358979323846), (float)(0.007292664737217109 / 3.14159265358979323846),
                              (float)(0.001414213562373095 / 3.14159265358979323846), (float)(0.0002742481756762073 / 3.14159265358979323846), (float)(5.318295896944988e-05 / 3.14159265358979323846), (float)(1.031338537721246e-05 / 3.14159265358979323846)};
        const float ilo[8] = {(float)(1.0 / 3.14159265358979323846 - (double)(float)(1.0 / 3.14159265358979323846)), (float)(0.19392274474868576 / 3.14159265358979323846 - (double)(float)(0.19392274474868576 / 3.14159265358979323846)),
                              (float)(0.03760603093086393 / 3.14159265358979323846 - (double)(float)(0.03760603093086393 / 3.14159265358979323846)), (float)(0.007292664737217109 / 3.14159265358979323846 - (double)(float)(0.007292664737217109 / 3.14159265358979323846)),
                              (float)(0.001414213562373095 / 3.14159265358979323846 - (double)(float)(0.001414213562373095 / 3.14159265358979323846)), (float)(0.0002742481756762073 / 3.14159265358979323846 - (double)(float)(0.0002742481756762073 / 3.14159265358979323846)),
                              (float)(5.318295896944988e-05 / 3.14159265358979323846 - (double)(float)(5.318295896944988e-05 / 3.14159265358979323846)), (float)(1.031338537721246e-05 / 3.14159265358979323846 - (double)(float)(1.031338537721246e-05 / 3.14159265358979323846))};
#pragma unroll
        for (int j = 0; j < 8; ++j) {
            const float fp = (float)pos, ph = fp * ihi[j], pe = __builtin_fmaf(fp, ihi[j], -ph) + fp * ilo[j];
            const float red = (ph - 2.0f * rintf(0.5f * ph)) + pe;
            const float2 cs = twid(0.5f * red); const float c = cs.x, s = cs.y;
            const float x1 = x[j], x2 = x[8 + j];
            x[j] = x1 * c - x2 * s; x[8 + j] = x2 * c + x1 * s;
        }
    }
    u32x4 o0, o1;
    o0.x = pk2(x[0] * scale, x[1] * scale); o0.y = pk2(x[2] * scale, x[3] * scale); o0.z = pk2(x[4] * scale, x[5] * scale); o0.w = pk2(x[6] * scale, x[7] * scale);
    o1.x = pk2(x[8] * scale, x[9] * scale); o1.y = pk2(x[10] * scale, x[11] * scale); o1.z = pk2(x[12] * scale, x[13] * scale); o1.w = pk2(x[14] * scale, x[15] * scale);
    *(u32x4*)dst = o0; *(u32x4*)(dst + 8) = o1;
}

__device__ __forceinline__ void ph_attn(KP p, int l, unsigned char* sm, int wv) {
    bf16_t* Ks = (bf16_t*)sm;
    bf16_t* Vt = (bf16_t*)(sm + 57600);
    bf16_t* Qs = (bf16_t*)(sm + 57600 + 51712);
    const bf16_t* Z = p->ZA;
    const int tid = otid(wv), wid = tid >> 6, lane = tid & 63, fr = lane & 15, fq = lane >> 4;
    const float* qg = p->q_norm + l * 64; const float* kg = p->k_norm + l * 64;
    for (int item0 = obid(); item0 < 768; item0 += ogrid()) {
        const int item = ogrid() == 256 ? (item0 & 7) * 96 + (item0 >> 8) * 32 + ((item0 & 255) >> 3) : item0;
        const int kvh = item / 384, qb = item - kvh * 384, Q0 = qb * 128;
        int sbase, L; seq_of(Q0, sbase, L);
        const int Q0rel = Q0 - sbase;
        const bool interior = Q0rel >= 128 && Q0rel + 256 <= L;
        __syncthreads();
        {
            u32x4 ka[4], kb[4], va[4], vb[4];
#pragma unroll
            for (int it = 0; it < 4; ++it) {
                const int idx = tid + 512 * it, row = idx >> 2, sub = idx & 3, prel = Q0rel - 128 + row;
                const bool inb = idx < 1600 && row < 384 && prel >= 0 && prel < L;
                ka[it] = (u32x4){0u, 0u, 0u, 0u}; kb[it] = ka[it]; va[it] = ka[it]; vb[it] = ka[it];
                if (inb) {
                    const bf16_t* src = Z + (size_t)(sbase + prel) * DIN + 512 + kvh * 64 + sub * 16;
                    ka[it] = *(const u32x4*)src; kb[it] = *(const u32x4*)(src + 8);
                    va[it] = *(const u32x4*)(src + 128); vb[it] = *(const u32x4*)(src + 136);
                }
            }
#pragma unroll
            for (int it = 0; it < 4; ++it) {
                const int idx = tid + 512 * it, row = idx >> 2, sub = idx & 3, prel = Q0rel - 128 + row;
                if (idx < 1600) {
                    qk_prep_store(ka[it], kb[it], kg, sub, prel, 1.0f, Ks + row * 72 + sub * 16, lane);
                    const unsigned vv[8] = {va[it].x, va[it].y, va[it].z, va[it].w, vb[it].x, vb[it].y, vb[it].z, vb[it].w};
#pragma unroll
                    for (int i = 0; i < 8; ++i) {
                        Vt[(sub * 16 + 2 * i) * 404 + row] = (bf16_t)(vv[i] & 0xffffu);
                        Vt[(sub * 16 + 2 * i + 1) * 404 + row] = (bf16_t)(vv[i] >> 16);
                    }
                }
            }
        }
        u32x4 qa[4], qb2[4];
#pragma unroll
        for (int g = 0; g < 4; ++g) {
            const bf16_t* src = Z + (size_t)(Q0 + (tid >> 2)) * DIN + (kvh * 4 + g) * 64 + (tid & 3) * 16;
            qa[g] = *(const u32x4*)src; qb2[g] = *(const u32x4*)(src + 8);
        }
        for (int g = 0; g < 4; ++g) {
            const int h = kvh * 4 + g;
            __syncthreads();
            {
                const int row = tid >> 2, sub = tid & 3;
                const u32x4 qsa = g == 0 ? qa[0] : (g == 1 ? qa[1] : (g == 2 ? qa[2] : qa[3])), qsb = g == 0 ? qb2[0] : (g == 1 ? qb2[1] : (g == 2 ? qb2[2] : qb2[3]));
                qk_prep_store(qsa, qsb, qg, sub, Q0rel + row, 0.125f, Qs + row * 72 + sub * 16, lane);
            }
            __syncthreads();
            bf16x8 qf[2];
#pragma unroll
            for (int ks = 0; ks < 2; ++ks) qf[ks] = *(const bf16x8*)(Qs + (16 * wid + fr) * 72 + 32 * ks + 8 * fq);
            f32x4 o[4];
#pragma unroll
            for (int dt = 0; dt < 4; ++dt) o[dt] = (f32x4){0.f, 0.f, 0.f, 0.f};
            float mrun = p->sink[l * 8 + h];
            float lsum = fq == 0 ? 1.0f : 0.0f;
            const int qi = 16 * wid + fr;
            for (int s = 0; s < 9; ++s) {
                const int kk0 = 16 * wid + 32 * s;
                f32x4 st[2];
#pragma unroll
                for (int kt = 0; kt < 2; ++kt) {
                    st[kt] = (f32x4){0.f, 0.f, 0.f, 0.f};
#pragma unroll
                    for (int ks = 0; ks < 2; ++ks) {
                        const bf16x8 kf = *(const bf16x8*)(Ks + (kk0 + 16 * kt + fr) * 72 + 32 * ks + 8 * fq);
                        st[kt] = __builtin_amdgcn_mfma_f32_16x16x32_bf16(kf, qf[ks], st[kt], 0, 0, 0);
                    }
                }
                float sv[2][4]; float mx = -1e30f;
                if (interior && s >= 1 && s <= 7) {
#pragma unroll
                    for (int kt = 0; kt < 2; ++kt)
#pragma unroll
                        for (int r = 0; r < 4; ++r) { sv[kt][r] = st[kt][r]; mx = fmaxf(mx, sv[kt][r]); }
                } else {
#pragma unroll
                    for (int kt = 0; kt < 2; ++kt)
#pragma unroll
                        for (int r = 0; r < 4; ++r) {
                            const int kk = kk0 + 16 * kt + 4 * fq + r, d = kk - 128 - qi, prel = Q0rel + kk - 128;
                            const bool valid = d >= -128 && d <= 128 && prel >= 0 && prel < L && kk < 384;
                            sv[kt][r] = valid ? st[kt][r] : -1e30f;
                            mx = fmaxf(mx, sv[kt][r]);
                        }
                }
                mx = fmaxf(mx, shx(mx, 16, lane)); mx = fmaxf(mx, shx(mx, 32, lane));
                const float mn = fmaxf(mrun, mx), alpha = __expf(mrun - mn);
                mrun = mn;
                float pr[2][4], psum = 0.f;
#pragma unroll
                for (int kt = 0; kt < 2; ++kt)
#pragma unroll
                    for (int r = 0; r < 4; ++r) { pr[kt][r] = __expf(sv[kt][r] - mn); psum += pr[kt][r]; }
                lsum = lsum * alpha + psum;
                union { bf16x8 v; unsigned u[4]; } pf;
                pf.u[0] = pk2(pr[0][0], pr[0][1]); pf.u[1] = pk2(pr[0][2], pr[0][3]); pf.u[2] = pk2(pr[1][0], pr[1][1]); pf.u[3] = pk2(pr[1][2], pr[1][3]);
#pragma unroll
                for (int dt = 0; dt < 4; ++dt) {
                    o[dt] = o[dt] * alpha;
                    union { bf16x8 v; u32x2 h[2]; } vf;
                    vf.h[0] = *(const u32x2*)(Vt + (16 * dt + fr) * 404 + kk0 + 4 * fq);
                    vf.h[1] = *(const u32x2*)(Vt + (16 * dt + fr) * 404 + kk0 + 16 + 4 * fq);
                    o[dt] = __builtin_amdgcn_mfma_f32_16x16x32_bf16(vf.v, pf.v, o[dt], 0, 0, 0);
                }
            }
            lsum += shx(lsum, 16, lane); lsum += shx(lsum, 32, lane);
            const float il = frcp(lsum);
            bf16_t* dst = p->Y + (size_t)(Q0 + qi) * DM + h * 64 + 4 * fq;
#pragma unroll
            for (int dt = 0; dt < 4; ++dt) { u32x2 w; w.x = pk2(o[dt].x * il, o[dt].y * il); w.y = pk2(o[dt].z * il, o[dt].w * il); *(u32x2*)(dst + 16 * dt) = w; }
        }
    }
}

__device__ __forceinline__ void ph_hyena_pre(KP p, int l, unsigned char* sm, int wv) {
    constexpr int ZS = 513;
    unsigned* zt = (unsigned*)sm;
    bf16_t* vt = (bf16_t*)(sm + 34 * ZS * 4);
    float* cw = (float*)(sm + 34 * ZS * 4 + 512 * 80);
    const bf16_t* Z = p->ZA;
    const int tid = otid(wv), tt = tid & 31, cg = tid >> 5;
    const float* ws = p->w_short + (size_t)l * 3 * 1536; const float* bs = p->b_short + l * 1536;
    __syncthreads();
    cw[tid] = ws[512 + tid]; cw[512 + tid] = ws[1536 + 512 + tid]; cw[1024 + tid] = ws[3072 + 512 + tid]; cw[1536 + tid] = bs[512 + tid];
    cw[2048 + tid] = ws[1024 + tid]; cw[2560 + tid] = ws[1536 + 1024 + tid]; cw[3072 + tid] = ws[3072 + 1024 + tid]; cw[3584 + tid] = bs[1024 + tid];
    u32x4 pre[9];
    {
        const int t0 = obid() * 32; int sbase, L; seq_of(t0, sbase, L);
#pragma unroll
        for (int i = 0; i < 9; ++i) {
            const int q = tid + 512 * i, r = q >> 7, ch = q & 127, t = t0 - 1 + r;
            pre[i] = (u32x4){0u, 0u, 0u, 0u};
            if (q < 34 * 128 && t >= sbase && t < sbase + L) pre[i] = *(const u32x4*)(Z + (size_t)t * DIN + 1280 + ch * 8);
        }
    }
    for (int tile = obid(); tile < 1536; tile += ogrid()) {
        const int t0 = tile * 32;
        __syncthreads();
#pragma unroll
        for (int i = 0; i < 9; ++i) {
            const int q = tid + 512 * i, r = q >> 7, ch = q & 127;
            if (q < 34 * 128) { unsigned* d = zt + r * ZS + ch * 4; d[0] = pre[i].x; d[1] = pre[i].y; d[2] = pre[i].z; d[3] = pre[i].w; }
        }
        __syncthreads();
        {
            const int tn = tile + ogrid();
            if (tn < 1536) {
                const int t0n = tn * 32; int sbn, Ln; seq_of(t0n, sbn, Ln);
#pragma unroll
                for (int i = 0; i < 9; ++i) {
                    const int q = tid + 512 * i, r = q >> 7, ch = q & 127, t = t0n - 1 + r;
                    pre[i] = (u32x4){0u, 0u, 0u, 0u};
                    if (q < 34 * 128 && t >= sbn && t < sbn + Ln) pre[i] = *(const u32x4*)(Z + (size_t)t * DIN + 1280 + ch * 8);
                }
            }
        }
#pragma unroll 4
        for (int i = 0; i < 16; ++i) {
            const int c = cg * 32 + 2 * i;
            const unsigned a_p = zt[tt * ZS + (c >> 1)], a_c = zt[(tt + 1) * ZS + (c >> 1)], a_n = zt[(tt + 2) * ZS + (c >> 1)];
            const unsigned g_p = zt[tt * ZS + 256 + (c >> 1)], g_c = zt[(tt + 1) * ZS + 256 + (c >> 1)], g_n = zt[(tt + 2) * ZS + 256 + (c >> 1)];
            const float u1a = cw[c] * bflo(a_p) + cw[512 + c] * bflo(a_c) + cw[1024 + c] * bflo(a_n) + cw[1536 + c];
            const float u2a = cw[2048 + c] * bflo(g_p) + cw[2560 + c] * bflo(g_c) + cw[3072 + c] * bflo(g_n) + cw[3584 + c];
            const float u1b = cw[c + 1] * bfhi(a_p) + cw[513 + c] * bfhi(a_c) + cw[1025 + c] * bfhi(a_n) + cw[1537 + c];
            const float u2b = cw[2049 + c] * bfhi(g_p) + cw[2561 + c] * bfhi(g_c) + cw[3073 + c] * bfhi(g_n) + cw[3585 + c];
            const unsigned pk = pk2(u1a * u2a, u1b * u2b);
            vt[c * 40 + tt] = (bf16_t)(pk & 0xffffu); vt[(c + 1) * 40 + tt] = (bf16_t)(pk >> 16);
        }
        __syncthreads();
#pragma unroll
        for (int i = 0; i < 4; ++i) {
            const int q = tid + 512 * i, cc = q >> 2, part = q & 3;
            *(u32x4*)(p->V + (size_t)cc * T + t0 + part * 8) = *(const u32x4*)(vt + cc * 40 + part * 8);
        }
    }
}

__device__ __forceinline__ void ph_filtergen(KP p, int l, unsigned char* sm, int wv) {
    float* zf = (float*)sm;
    float* h1 = zf + 64 * 34;
    float* h2 = h1 + 64 * 65;
    float* w1s = h2 + 64 * 68;
    float* w2s = w1s + 33 * 64;
    float* ot = w2s + 64 * 64;
    const int tid = otid(wv), wid = tid >> 6, lane = tid & 63;
    const float* b1 = p->fb1 + l * 64; const float* f1 = p->ffr1 + l * 64;
    const float* b2 = p->fb2 + l * 64; const float* f2 = p->ffr2 + l * 64;
    const float* w3 = p->fw3 + (size_t)l * 65536; const float* hb = p->hbias + l * 512;
    __syncthreads();
    for (int i = tid; i < 33 * 64; i += 512) w1s[i] = p->fw1[l * 33 * 64 + i];
    for (int i = tid; i < 64 * 64; i += 512) w2s[i] = p->fw2[l * 4096 + i];
    for (int item = obid(); item < 384; item += ogrid()) {
        const int L = item < 256 ? LP : LSQ, n0 = (item < 256 ? item : item - 256) * 64;
        bf16_t* kf = p->X + (item < 256 ? 0 : 16777216);
        __syncthreads();
        {
            const int n = n0 + lane;
            const float w = 2.0f * (float)n / (float)L;
#pragma unroll
            for (int q = 0; q < 2; ++q) {
                const int b = wid * 2 + q;
                const float f = 1e-4f + (float)b * 0.9999933333333334f;
                const float ht = f * w, red = ht - 2.0f * rintf(0.5f * ht);
                const float2 cs = twid_precise(0.5f * red);
                zf[lane * 34 + 1 + b] = cs.x; zf[lane * 34 + 17 + b] = -cs.y;
            }
            if (wid == 0) zf[lane * 34] = (float)n / (float)(L - 1);
        }
        __syncthreads();
        {
            float a[8];
#pragma unroll
            for (int i = 0; i < 8; ++i) a[i] = b1[wid * 8 + i];
#pragma unroll 3
            for (int f = 0; f < 33; ++f) {
                const float zv = zf[lane * 34 + f];
                const f32x4 w0 = *(const f32x4*)(w1s + f * 64 + wid * 8), w1v = *(const f32x4*)(w1s + f * 64 + wid * 8 + 4);
                a[0] += zv * w0.x; a[1] += zv * w0.y; a[2] += zv * w0.z; a[3] += zv * w0.w; a[4] += zv * w1v.x; a[5] += zv * w1v.y; a[6] += zv * w1v.z; a[7] += zv * w1v.w;
            }
#pragma unroll
            for (int i = 0; i < 8; ++i) h1[lane * 65 + wid * 8 + i] = sinpif(f1[wid * 8 + i] * a[i] * 0.3183098861837907f);
        }
        __syncthreads();
        {
            float a[8];
#pragma unroll
            for (int i = 0; i < 8; ++i) a[i] = b2[wid * 8 + i];
#pragma unroll 4
            for (int j = 0; j < 64; ++j) {
                const float zv = h1[lane * 65 + j];
                const f32x4 w0 = *(const f32x4*)(w2s + j * 64 + wid * 8), w1v = *(const f32x4*)(w2s + j * 64 + wid * 8 + 4);
                a[0] += zv * w0.x; a[1] += zv * w0.y; a[2] += zv * w0.z; a[3] += zv * w0.w; a[4] += zv * w1v.x; a[5] += zv * w1v.y; a[6] += zv * w1v.z; a[7] += zv * w1v.w;
            }
#pragma unroll
            for (int i = 0; i < 8; ++i) h2[lane * 68 + wid * 8 + i] = sinpif(f2[wid * 8 + i] * a[i] * 0.3183098861837907f);
        }
        __syncthreads();
#pragma unroll 1
        for (int pass = 0; pass < 4; ++pass) {
            const int ol = tid & 255, o = pass * 256 + ol, ph0 = (tid >> 8) * 32;
            float wcol[64];
#pragma unroll
            for (int j = 0; j < 64; ++j) wcol[j] = w3[j * 1024 + o];
#pragma unroll 2
            for (int pp = 0; pp < 32; ++pp) {
                const f32x4* hr = (const f32x4*)(h2 + (ph0 + pp) * 68);
                float acc0 = 0.f, acc1 = 0.f;
#pragma unroll
                for (int j4 = 0; j4 < 16; ++j4) { const f32x4 hv = hr[j4]; acc0 += hv.x * wcol[j4 * 4] + hv.z * wcol[j4 * 4 + 2]; acc1 += hv.y * wcol[j4 * 4 + 1] + hv.w * wcol[j4 * 4 + 3]; }
                ot[ol * 65 + ph0 + pp] = acc0 + acc1;
            }
            __syncthreads();
            for (int e = tid; e < 256 * 64; e += 512) {
                const int ol2 = e >> 6, pos = e & 63, o2 = pass * 256 + ol2, c = o2 & 511, n = n0 + pos;
                const float tt = (float)n / (float)(L - 1);
                const float delta = fabsf(-3.070113457325394f + (float)c * ((-15.350567286626971f + 3.070113457325394f) / 511.0f));
                float val = ot[ol2 * 65 + pos] * __expf(-tt * delta);
                bf16_t* kc = kf + (size_t)c * (2 * L);
                if (o2 < 512) { if (n == 0) val += hb[c]; kc[n] = (bf16_t)(pk2(val, 0.f) & 0xffffu); }
                else { if (n >= 1) kc[2 * L - n] = (bf16_t)(pk2(val, 0.f) & 0xffffu); else kc[L] = (bf16_t)0; }
            }
            __syncthreads();
        }
    }
}

__device__ __forceinline__ float2 cmul(float2 a, float2 b) { return make_float2(a.x * b.x - a.y * b.y, a.x * b.y + a.y * b.x); }
__device__ __forceinline__ float2 cadd(float2 a, float2 b) { return make_float2(a.x + b.x, a.y + b.y); }
__device__ __forceinline__ float2 csub(float2 a, float2 b) { return make_float2(a.x - b.x, a.y - b.y); }

__device__ __forceinline__ int PD(int i) { return i + (i >> 4); }
template <bool TW>
__device__ __forceinline__ void fft16_fwd(float2 (&x)[16], float2 T1) {
    const float C[8] = {1.0f, 0.92387953251128674f, 0.70710678118654752f, 0.38268343236508977f, 0.0f, -0.38268343236508977f, -0.70710678118654752f, -0.92387953251128674f};
    const float S[8] = {0.0f, 0.38268343236508977f, 0.70710678118654752f, 0.92387953251128674f, 1.0f, 0.92387953251128674f, 0.70710678118654752f, 0.38268343236508977f};
    float2 Ts = T1;
#pragma unroll
    for (int st = 0; st < 4; ++st) {
        const int half = 8 >> st;
#pragma unroll
        for (int i = 0; i < 8; ++i) {
            const int g = i / half, j = i % half, pp = g * 2 * half + j, ti = j * (8 / half);
            const float2 a = x[pp], b = x[pp + half], d = csub(a, b);
            x[pp] = cadd(a, b);
            const float2 dw = cmul(d, make_float2(C[ti], -S[ti]));
            x[pp + half] = TW ? cmul(dw, Ts) : dw;
        }
        if (TW) Ts = cmul(Ts, Ts);
    }
}
template <bool TW>
__device__ __forceinline__ void fft16_inv(float2 (&x)[16], float2 T1c) {
    const float C[8] = {1.0f, 0.92387953251128674f, 0.70710678118654752f, 0.38268343236508977f, 0.0f, -0.38268343236508977f, -0.70710678118654752f, -0.92387953251128674f};
    const float S[8] = {0.0f, 0.38268343236508977f, 0.70710678118654752f, 0.92387953251128674f, 1.0f, 0.92387953251128674f, 0.70710678118654752f, 0.38268343236508977f};
    const float2 T2 = cmul(T1c, T1c), T4 = cmul(T2, T2), T8 = cmul(T4, T4);
#pragma unroll
    for (int st = 0; st < 4; ++st) {
        const int half = 1 << st;
        const float2 Ts = st == 0 ? T8 : (st == 1 ? T4 : (st == 2 ? T2 : T1c));
#pragma unroll
        for (int i = 0; i < 8; ++i) {
            const int g = i / half, j = i % half, pp = g * 2 * half + j, ti = j * (8 / half);
            const float2 bw = cmul(x[pp + half], make_float2(C[ti], S[ti]));
            const float2 a = x[pp], b = TW ? cmul(bw, Ts) : bw;
            x[pp] = cadd(a, b); x[pp + half] = csub(a, b);
        }
    }
}
template <bool FWD>
__device__ __forceinline__ void fft_pass16(float2* z, int Lc, int ls, int tid) {
    const int s = 1 << ls, os = ls >= 4 ? s + (s >> 4) : 1;
    const float its = 0.0625f / (float)s;
    for (int q = tid; q < (Lc >> 4); q += 512) {
        const int g = q >> ls, j = q & (s - 1), pb = PD((g << (ls + 4)) + j);
        float2 x[16];
#pragma unroll
        for (int k = 0; k < 16; ++k) x[k] = z[pb + k * os];
        if (ls == 0) { if (FWD) fft16_fwd<false>(x, make_float2(1.f, 0.f)); else fft16_inv<false>(x, make_float2(1.f, 0.f)); }
        else { const float2 T1 = twid((FWD ? -1.0f : 1.0f) * (float)j * its); if (FWD) fft16_fwd<true>(x, T1); else fft16_inv<true>(x, T1); }
#pragma unroll
        for (int k = 0; k < 16; ++k) z[pb + k * os] = x[k];
    }
    __syncthreads();
}
__device__ __forceinline__ void fft_fwd(float2* z, int lg, int tid) {
    const int Lc = 1 << lg; const int lh = lg - 1;
    if (lg & 1) {
        const int h = 1 << lh, oh = h + (h >> 4);
        for (int j = tid; j < h; j += 512) {
            const int pj = PD(j);
            const float2 a = z[pj], b = z[pj + oh];
            z[pj] = cadd(a, b); z[pj + oh] = cmul(csub(a, b), twid(-(float)j * (0.5f / (float)h)));
        }
        __syncthreads();
    } else {
        const int h = 1 << lh, hh = h >> 1, oh = h + (h >> 4), ohh = hh + (hh >> 4);
        const float ih2 = 0.5f / (float)h;
        for (int q0 = tid; q0 < (Lc >> 2); q0 += 2048) {
            float2 x[4][4]; int pbs[4]; float2 w1s[4];
#pragma unroll
            for (int u = 0; u < 4; ++u) {
                const int q = q0 + 512 * u, g = q >> (lh - 1), j = q & (hh - 1), pb = PD((g << (lh + 1)) + j);
                pbs[u] = pb; w1s[u] = twid(-(float)j * ih2);
                x[u][0] = z[pb]; x[u][1] = z[pb + ohh]; x[u][2] = z[pb + oh]; x[u][3] = z[pb + oh + ohh];
            }
#pragma unroll
            for (int u = 0; u < 4; ++u) {
                const float2 w1 = w1s[u], w2 = cmul(w1, w1);
                const float2 a0 = cadd(x[u][0], x[u][2]), a2 = cmul(csub(x[u][0], x[u][2]), w1), a1 = cadd(x[u][1], x[u][3]), t3 = cmul(csub(x[u][1], x[u][3]), w1);
                const float2 a3 = make_float2(t3.y, -t3.x);
                x[u][0] = cadd(a0, a1); x[u][1] = cmul(csub(a0, a1), w2); x[u][2] = cadd(a2, a3); x[u][3] = cmul(csub(a2, a3), w2);
            }
#pragma unroll
            for (int u = 0; u < 4; ++u) { const int pb = pbs[u]; z[pb] = x[u][0]; z[pb + ohh] = x[u][1]; z[pb + oh] = x[u][2]; z[pb + oh + ohh] = x[u][3]; }
        }
        __syncthreads();
    }
    fft_pass16<true>(z, Lc, 8, tid);
    fft_pass16<true>(z, Lc, 4, tid);
    fft_pass16<true>(z, Lc, 0, tid);
}
__device__ __forceinline__ void fft_inv(float2* z, int lg, int tid) {
    const int Lc = 1 << lg; const int lh = 12;
    fft_pass16<false>(z, Lc, 0, tid);
    fft_pass16<false>(z, Lc, 4, tid);
    fft_pass16<false>(z, Lc, 8, tid);
    if (lg & 1) {
        const int h = 1 << lh, oh = h + (h >> 4);
        for (int j = tid; j < h; j += 512) {
            const int pj = PD(j);
            const float2 a = z[pj], b = cmul(z[pj + oh], twid((float)j * (0.5f / (float)h)));
            z[pj] = cadd(a, b); z[pj + oh] = csub(a, b);
        }
        __syncthreads();
    } else {
        const int h = 1 << lh, oh = h + (h >> 4);
        const float ih4 = 0.25f / (float)h;
        for (int q0 = tid; q0 < (Lc >> 2); q0 += 2048) {
            float2 x[4][4]; int pbs[4]; float2 cws[4];
#pragma unroll
            for (int u = 0; u < 4; ++u) {
                const int q = q0 + 512 * u, g = q >> lh, j = q & (h - 1), pb = PD((g << (lh + 2)) + j);
                pbs[u] = pb; cws[u] = twid((float)j * ih4);
                x[u][0] = z[pb]; x[u][1] = z[pb + oh]; x[u][2] = z[pb + 2 * oh]; x[u][3] = z[pb + 3 * oh];
            }
#pragma unroll
            for (int u = 0; u < 4; ++u) {
                const float2 cwb = cws[u], cwa = cmul(cwb, cwb);
                const float2 t1 = cmul(x[u][1], cwa), a0 = cadd(x[u][0], t1), a1 = csub(x[u][0], t1), t3 = cmul(x[u][3], cwa), a2 = cadd(x[u][2], t3), a3 = csub(x[u][2], t3);
                const float2 u2 = cmul(a2, cwb), u3t = cmul(a3, cwb), u3 = make_float2(-u3t.y, u3t.x);
                x[u][0] = cadd(a0, u2); x[u][2] = csub(a0, u2); x[u][1] = cadd(a1, u3); x[u][3] = csub(a1, u3);
            }
#pragma unroll
            for (int u = 0; u < 4; ++u) { const int pb = pbs[u]; z[pb] = x[u][0]; z[pb + oh] = x[u][1]; z[pb + 2 * oh] = x[u][2]; z[pb + 3 * oh] = x[u][3]; }
        }
        __syncthreads();
    }
}

__device__ __forceinline__ void ph_filter_fft(KP p, unsigned char* sm, int wv) {
    float2* z = (float2*)sm;
    const int tid = otid(wv);
    for (int item = obid(); item < 1024; item += ogrid()) {
        const int big = item < 512, c = item & 511, lg = big ? 14 : 13, Lc = 1 << lg;
        unsigned* g = (unsigned*)p->X + (big ? 0 : 8388608) + (size_t)c * Lc;
        __syncthreads();
#pragma unroll 4
        for (int i = tid; i < (Lc >> 2); i += 512) {
            const u32x4 v = *(const u32x4*)(g + 4 * i); const int pi = PD(4 * i);
            z[pi] = make_float2(bflo(v.x), bfhi(v.x)); z[pi + 1] = make_float2(bflo(v.y), bfhi(v.y)); z[pi + 2] = make_float2(bflo(v.z), bfhi(v.z)); z[pi + 3] = make_float2(bflo(v.w), bfhi(v.w));
        }
        __syncthreads();
        fft_fwd(z, lg, tid);
        const float sc = 1.0f / (float)Lc;
        for (int k = tid; k <= (Lc >> 1); k += 512) {
            if (k == 0) { const float2 Z0 = z[0]; g[0] = pk2((Z0.x + Z0.y) * sc, (Z0.x - Z0.y) * sc); continue; }
            const int pk = (int)(__brev((unsigned)k) >> (32 - lg)), pm = (int)(__brev((unsigned)(Lc - k)) >> (32 - lg));
            const float2 Zk = z[PD(pk)], Zm = z[PD(pm)];
            const float2 E = make_float2(0.5f * (Zk.x + Zm.x), 0.5f * (Zk.y - Zm.y));
            const float2 O = make_float2(0.5f * (Zk.y + Zm.y), -0.5f * (Zk.x - Zm.x));
            const float2 wO = cmul(twid(-(float)k * (0.5f / (float)Lc)), O);
            const float2 Xk = cadd(E, wO), Xm0 = csub(E, wO);
            g[k] = pk2(Xk.x * sc, Xk.y * sc);
            g[Lc - k] = pk2(Xm0.x * sc, -Xm0.y * sc);
        }
    }
}

template <int LG>
__device__ __forceinline__ void pair_one(float2* z, int k, float2 Kk, float2 Km) {
    constexpr int Lc = 1 << LG;
    const int pk = (int)(__brev((unsigned)k) >> (32 - LG)), pm = (int)(__brev((unsigned)(Lc - k)) >> (32 - LG));
    const float2 Zk = z[PD(pk)], Zm = z[PD(pm)];
    const float2 E = make_float2(0.5f * (Zk.x + Zm.x), 0.5f * (Zk.y - Zm.y));
    const float2 O = make_float2(0.5f * (Zk.y + Zm.y), -0.5f * (Zk.x - Zm.x));
    const float2 w = twid(-(float)k * (0.5f / (float)Lc));
    const float2 wO = cmul(w, O);
    const float2 Xk = cadd(E, wO), Xm0 = csub(E, wO), Xm = make_float2(Xm0.x, -Xm0.y);
    const float2 Yk = cmul(Xk, Kk), Ym = cmul(Xm, Km);
    const float2 E2 = make_float2(0.5f * (Yk.x + Ym.x), 0.5f * (Yk.y - Ym.y));
    const float2 D2 = make_float2(0.5f * (Yk.x - Ym.x), 0.5f * (Yk.y + Ym.y));
    const float2 O2 = cmul(D2, make_float2(w.x, -w.y));
    z[PD(pk)] = make_float2(E2.x - O2.y, E2.y + O2.x);
    if (pm != pk) z[PD(pm)] = make_float2(E2.x + O2.y, -E2.y + O2.x);
}
template <int LG, int NSEQ>
__device__ __forceinline__ void fftconv_channel(float2* z, const unsigned* spec, bf16_t* v0, int tid0) {
    constexpr int Lc = 1 << LG, NK = Lc / 1024, NL = Lc / 4096;
    unsigned sku[NK], smu[NK];
#pragma unroll
    for (int i = 0; i < NK; ++i) { const int k = tid0 + 512 * i; sku[i] = spec[k]; smu[i] = spec[(Lc - k) & (Lc - 1)]; }
    const unsigned shu = spec[Lc >> 1];
#pragma unroll 1
    for (int sq = 0; sq < NSEQ; ++sq) {
        int tid = tid0; asm volatile("" : "+v"(tid));
        bf16_t* v = v0 + (size_t)sq * Lc;
        u32x4 raw[NL];
#pragma unroll
        for (int i = 0; i < NL; ++i) raw[i] = *(const u32x4*)(v + 8 * (tid + 512 * i));
        __syncthreads();
#pragma unroll
        for (int i = 0; i < NL; ++i) {
            const int pi = PD(4 * (tid + 512 * i));
            z[pi] = make_float2(bflo(raw[i].x), bfhi(raw[i].x)); z[pi + 1] = make_float2(bflo(raw[i].y), bfhi(raw[i].y));
            z[pi + 2] = make_float2(bflo(raw[i].z), bfhi(raw[i].z)); z[pi + 3] = make_float2(bflo(raw[i].w), bfhi(raw[i].w));
        }
        for (int i = (Lc >> 1) + tid; i < Lc; i += 512) z[PD(i)] = make_float2(0.f, 0.f);
        int lgv = LG; asm volatile("" : "+s"(lgv));
        __syncthreads();
        fft_fwd(z, lgv, tid);
#pragma unroll
        for (int i = 0; i < NK; ++i) {
            int tz = 0; asm volatile("" : "+v"(tz));
            const int k = tid + tz + 512 * i;
            if (k == 0) { const float2 Z0 = z[0], K0 = make_float2(bflo(sku[0]), bfhi(sku[0])); const float Y0 = (Z0.x + Z0.y) * K0.x, YL = (Z0.x - Z0.y) * K0.y; z[0] = make_float2(0.5f * (Y0 + YL), 0.5f * (Y0 - YL)); }
            else pair_one<LG>(z, k, make_float2(bflo(sku[i]), bfhi(sku[i])), make_float2(bflo(smu[i]), bfhi(smu[i])));
        }
        if (tid == 0) pair_one<LG>(z, Lc >> 1, make_float2(bflo(shu), bfhi(shu)), make_float2(bflo(shu), bfhi(shu)));
        __syncthreads();
        fft_inv(z, lgv, tid);
#pragma unroll
        for (int i = 0; i < NL; ++i) {
            const int pi = PD(4 * (tid + 512 * i)); const float2 a = z[pi], b = z[pi + 1], cc = z[pi + 2], d = z[pi + 3];
            u32x4 o; o.x = pk2(a.x, a.y); o.y = pk2(b.x, b.y); o.z = pk2(cc.x, cc.y); o.w = pk2(d.x, d.y);
            *(u32x4*)(v + 8 * (tid + 512 * i)) = o;
        }
    }
}
__device__ __forceinline__ void ph_fftconv(KP p, unsigned char* sm, int wv) {
    float2* z = (float2*)sm;
    const int tid0 = otid(wv);
    for (int c = obid(); c < 512; c += ogrid()) {
        int tid = tid0; asm volatile("" : "+v"(tid));
        fftconv_channel<14, 1>(z, (const unsigned*)p->X + (size_t)c * 16384, p->V + (size_t)c * T, tid);
        asm volatile("" : "+v"(tid));
        fftconv_channel<13, 4>(z, (const unsigned*)p->X + 8388608 + (size_t)c * 8192, p->V + (size_t)c * T + LP, tid);
    }
}

__device__ __forceinline__ void ph_mixfinal(KP p, int l, unsigned char* sm, int wv) {
    constexpr int ZS = 257;
    bf16_t* yt = (bf16_t*)sm;
    unsigned* zt = (unsigned*)(sm + 73728);
    float* part = (float*)(sm + 73728 + 66 * ZS * 4);
    float* cw = part + 512;
    const bf16_t* Z = p->ZA;
    const int tid = otid(wv), wid = tid >> 6, lane = tid & 63, tt = lane, cg = wid;
    const float* ws = p->w_short + (size_t)l * 3 * 1536; const float* bs = p->b_short + l * 1536;
    const float* gh = p->nho + l * 512;
    __syncthreads();
    cw[tid] = ws[tid]; cw[512 + tid] = ws[1536 + tid]; cw[1024 + tid] = ws[3072 + tid]; cw[1536 + tid] = bs[tid];
    for (int tile = obid(); tile < 768; tile += ogrid()) {
        const int t0 = tile * 64; int sbase, L; seq_of(t0, sbase, L);
        const int tend = sbase + L;
        u32x4 arow[8];
#pragma unroll
        for (int i = 0; i < 8; ++i) arow[i] = *(const u32x4*)(p->Y + (size_t)(t0 + wid * 8 + i) * DM + lane * 8);
        __syncthreads();
#pragma unroll
        for (int i = 0; i < 8; ++i) {
            const int q = tid + 512 * i, cc = q >> 3, pt = q & 7;
            *(u32x4*)(yt + cc * 72 + pt * 8) = *(const u32x4*)(p->V + (size_t)cc * T + t0 + pt * 8);
        }
        for (int q = tid; q < 66 * 64; q += 512) {
            const int r = q >> 6, ch = q & 63, t = t0 - 1 + r;
            u32x4 v = (u32x4){0u, 0u, 0u, 0u};
            if (t >= sbase && t < tend) v = *(const u32x4*)(Z + (size_t)t * DIN + 768 + ch * 8);
            unsigned* d = zt + r * ZS + ch * 4;
            d[0] = v.x; d[1] = v.y; d[2] = v.z; d[3] = v.w;
        }
        __syncthreads();
        unsigned hyp[32]; float sq = 0.f;
#pragma unroll
        for (int i = 0; i < 32; ++i) {
            const int c = cg * 64 + 2 * i;
            const unsigned z_p = zt[tt * ZS + (c >> 1)], z_c = zt[(tt + 1) * ZS + (c >> 1)], z_n = zt[(tt + 2) * ZS + (c >> 1)];
            const float x0a = cw[c] * bflo(z_p) + cw[512 + c] * bflo(z_c) + cw[1024 + c] * bflo(z_n) + cw[1536 + c];
            const float x0b = cw[c + 1] * bfhi(z_p) + cw[513 + c] * bfhi(z_c) + cw[1025 + c] * bfhi(z_n) + cw[1537 + c];
            const float ha = x0a * bf1(yt[c * 72 + tt]), hb = x0b * bf1(yt[(c + 1) * 72 + tt]);
            sq += ha * ha + hb * hb;
            hyp[i] = pk2(ha, hb);
        }
        part[tt * 8 + cg] = sq;
        __syncthreads();
        {
            const f32x4 q0 = *(const f32x4*)(part + tt * 8), q1 = *(const f32x4*)(part + tt * 8 + 4);
            const float sm_ = ((q0.x + q0.y) + (q0.z + q0.w)) + ((q1.x + q1.y) + (q1.z + q1.w));
            const float r = rsqrtf(sm_ * (1.0f / 512.0f) + EPS);
            bf16_t* dst = p->Y + (size_t)(t0 + tt) * DM + 512 + cg * 64;
#pragma unroll
            for (int i8 = 0; i8 < 8; ++i8) {
                const f32x4 g0 = *(const f32x4*)(gh + cg * 64 + i8 * 8), g1 = *(const f32x4*)(gh + cg * 64 + i8 * 8 + 4);
                u32x4 o;
                o.x = pk2(bflo(hyp[i8 * 4]) * r * g0.x, bfhi(hyp[i8 * 4]) * r * g0.y); o.y = pk2(bflo(hyp[i8 * 4 + 1]) * r * g0.z, bfhi(hyp[i8 * 4 + 1]) * r * g0.w);
                o.z = pk2(bflo(hyp[i8 * 4 + 2]) * r * g1.x, bfhi(hyp[i8 * 4 + 2]) * r * g1.y); o.w = pk2(bflo(hyp[i8 * 4 + 3]) * r * g1.z, bfhi(hyp[i8 * 4 + 3]) * r * g1.w);
                *(u32x4*)(dst + i8 * 8) = o;
            }
        }
        const f32x4 ga0 = *(const f32x4*)(p->nao + l * 512 + lane * 8), ga1 = *(const f32x4*)(p->nao + l * 512 + lane * 8 + 4);
#pragma unroll
        for (int i = 0; i < 8; ++i) {
            const int t = t0 + wid * 8 + i;
            bf16_t* rowp = p->Y + (size_t)t * DM + lane * 8;
            const u32x4 raw = arow[i];
            float x[8] = {bflo(raw.x), bfhi(raw.x), bflo(raw.y), bfhi(raw.y), bflo(raw.z), bfhi(raw.z), bflo(raw.w), bfhi(raw.w)};
            float s = 0.f;
#pragma unroll
            for (int k = 0; k < 8; ++k) s += x[k] * x[k];
            s = wave_sum(s, lane);
            const float r = rsqrtf(s * (1.0f / 512.0f) + EPS);
            u32x4 o; o.x = pk2(x[0] * r * ga0.x, x[1] * r * ga0.y); o.y = pk2(x[2] * r * ga0.z, x[3] * r * ga0.w); o.z = pk2(x[4] * r * ga1.x, x[5] * r * ga1.y); o.w = pk2(x[6] * r * ga1.z, x[7] * r * ga1.w);
            *(u32x4*)rowp = o;
        }
    }
}

enum { OP_XCONV = 0, OP_WCONV, OP_GEMM_IN, OP_FILTERGEN, OP_ATTN, OP_HPRE, OP_FFFT, OP_FFTCONV, OP_MIXFINAL, OP_GEMM_OUT, OP_PCONV, OP_GEMM_UP, OP_GEMM_DOWN, OP_GEMM_GATE, OP_GEMM_PROJ };
__global__ void __launch_bounds__(512, 2) mega(P p_arg) {
    extern __shared__ __attribute__((aligned(16))) unsigned char smem[];
    LAS unsigned char* lds = (LAS unsigned char*)smem;
    const int nseq = p_arg.nseq;
    const int wv = __builtin_amdgcn_readfirstlane((int)(threadIdx.x >> 6));
    for (int si = 0; si < nseq; ++si) {
        KP p = (KP)__builtin_amdgcn_kernarg_segment_ptr();
        asm volatile("" : "+s"(p));
        const int code = __builtin_amdgcn_readfirstlane(p->seq[si]), op = code & 31, l = (code >> 5) & 3;
        const bf16_t* Wl = p->W + (size_t)(l & 1) * W_LAYER;
        if (op == OP_XCONV) ph_xconv(p, wv);
        else if (op == OP_WCONV) ph_wconv(p, l, smem, wv);
        else if (op == OP_GEMM_IN) { Sched S; S.init(192, 9, 0); EpiIn E{p->ZA, p->ss_in}; gemm_phase(lds, l == 0 ? (const bf16_t*)p->Y : (const bf16_t*)p->out, Wl + WO_IN, 1024, S, E, wv); }
        else if (op == OP_FILTERGEN) ph_filtergen(p, l, smem, wv);
        else if (op == OP_ATTN) ph_attn(p, l, smem, wv);
        else if (op == OP_HPRE) ph_hyena_pre(p, l, smem, wv);
        else if (op == OP_FFFT) ph_filter_fft(p, smem, wv);
        else if (op == OP_FFTCONV) ph_fftconv(p, smem, wv);
        else if (op == OP_MIXFINAL) ph_mixfinal(p, l, smem, wv);
        else if (op == OP_GEMM_OUT) { Sched S; S.init(192, 4, 0); EpiRes E{p->xp, p->xs, (const bf16_t*)p->out, p->X, p->ss_ffn, l == 0 ? 0 : 1}; gemm_phase(lds, p->Y, Wl + WO_OUT, 1024, S, E, wv); }
        else if (op == OP_PCONV) ph_pconv(p, l, wv);
        else if (op == OP_GEMM_UP) { Sched S; S.init(197, 22, 1); EpiUp E{p->ZA, p->ss_ffn, p->w_ffconv + (size_t)l * 3 * 5632, p->b_ffconv + (size_t)l * 5632}; gemm_phase(lds, p->X, Wl + WO_UP, 1024, S, E, wv); }
        else if (op == OP_GEMM_DOWN) { Sched S; S.init(192, 4, 0); EpiRes E{p->xp, p->xs, p->X, p->X, nullptr, 1}; gemm_phase(lds, p->ZA, Wl + WO_DOWN, 2816, S, E, wv); }
        else if (op == OP_GEMM_GATE) { Sched S; S.init(192, 4, 0); EpiGate E{p->ZA}; gemm_phase(lds, p->X, Wl + WO_GATE, 1024, S, E, wv); }
        else { Sched S; S.init(192, 4, 0); EpiProj E{p->ZA, p->X, p->out, (bf16_t*)p->out, p->ss_in, l == NLAYER - 1 ? 1 : 0}; gemm_phase(lds, p->V, Wl + WO_PROJ, 256, S, E, wv); }
        if (code & 128) { if (si + 1 < nseq) cg::this_grid().sync(); }
        else __syncthreads();
    }
}

extern "C" void kernel_launch(void* const* d_in, const int* in_sizes, int n_in, void* d_out, int out_size, void* d_ws, size_t ws_size, hipStream_t stream) {
    static int grid = 0;
    if (grid == 0) {
        if (n_in != 29 || out_size != T * DM || ws_size < WS_END) { fprintf(stderr, "kernel_launch: unexpected shapes (n_in %d out %d ws %zu need %zu)\n", n_in, out_size, ws_size, (size_t)WS_END); grid = -1; return; }
        int dev = 0, cus = 0, per_cu = 0;
        hipGetDevice(&dev);
        hipDeviceGetAttribute(&cus, hipDeviceAttributeMultiprocessorCount, dev);
        if (hipFuncSetAttribute((const void*)mega, hipFuncAttributeMaxDynamicSharedMemorySize, LDS_BYTES) != hipSuccess) { fprintf(stderr, "kernel_launch: hipFuncSetAttribute failed\n"); grid = -1; return; }
        if (hipOccupancyMaxActiveBlocksPerMultiprocessor(&per_cu, (const void*)mega, 512, LDS_BYTES) != hipSuccess || per_cu < 1) per_cu = 1;
        (void)hipGetLastError();
        grid = cus * per_cu;
    }
    if (grid < 0) return;
    P p{};
    const float** f = (const float**)&p;
    for (int i = 0; i < 29; ++i) f[i] = (const float*)d_in[i];
    p.out = (float*)d_out;
    unsigned char* ws = (unsigned char*)d_ws;
    p.X = (bf16_t*)(ws + OFF_X); p.Y = (bf16_t*)(ws + OFF_Y); p.ZA = (bf16_t*)(ws + OFF_ZA); p.V = (bf16_t*)(ws + OFF_V); p.W = (bf16_t*)(ws + OFF_W);
    p.ss_in = (float*)(ws + OFF_SSI); p.ss_ffn = (float*)(ws + OFF_SSF);
    int ns = 0;
#define EMIT(op, l, sync) p.seq[ns++] = ((op) | ((l) << 5) | ((sync) ? 128 : 0))
    EMIT(OP_XCONV, 0, 0); EMIT(OP_WCONV, 0, 1);
    for (int l = 0; l < NLAYER; ++l) {
        EMIT(OP_GEMM_IN, l, 0); EMIT(OP_FILTERGEN, l, 1);
        EMIT(OP_ATTN, l, 0); EMIT(OP_HPRE, l, 0);
        if (l + 1 < NLAYER) { EMIT(OP_FFFT, l, 0); EMIT(OP_WCONV, l + 1, 1); } else EMIT(OP_FFFT, l, 1);
#if PROBE_MASK & 1
        EMIT(OP_ATTN, l, 1);
#endif
#if PROBE_MASK & 2
        EMIT(OP_HPRE, l, 1);
#endif
#if PROBE_MASK & 4
        EMIT(OP_FILTERGEN, l, 1); EMIT(OP_FFFT, l, 1);
#endif
#if PROBE_MASK & 8
        if (l + 1 < NLAYER) EMIT(OP_WCONV, l + 1, 1);
#endif
        EMIT(OP_FFTCONV, l, 1);
#if PROBE_MASK & 16
        EMIT(OP_HPRE, l, 1); EMIT(OP_FFTCONV, l, 1);
#endif
        EMIT(OP_MIXFINAL, l, 1);
#if PROBE_MASK & 32
        EMIT(OP_ATTN, l, 1); EMIT(OP_MIXFINAL, l, 1);
#endif
        EMIT(OP_GEMM_OUT, l, 0); EMIT(OP_PCONV, l, 1);
#if PROBE_MASK & 128
        for (int r = 0; r < 4; ++r) EMIT(OP_PCONV, l, 1);
#endif
        EMIT(OP_GEMM_UP, l, 1);
#if PROBE_MASK & 64
        EMIT(OP_GEMM_UP, l, 1);
#endif
        EMIT(OP_GEMM_DOWN, l, 1);
        EMIT(OP_GEMM_GATE, l, 0);
        EMIT(OP_GEMM_PROJ, l, 1);
    }
#undef EMIT
    p.nseq = ns;
    void* args[] = {&p};
    hipError_t e = hipLaunchCooperativeKernel((const void*)mega, dim3(grid), dim3(512), args, LDS_BYTES, stream);
    if (e != hipSuccess) fprintf(stderr, "cooperative launch failed: %s (grid %d)\n", hipGetErrorString(e), grid);
}
```

```cpp
#include <hip/hip_runtime.h>
#include <hip/hip_cooperative_groups.h>
#include <cstdio>
#include <cstdint>
namespace cg = cooperative_groups;

#ifndef PROBE_MASK
#define PROBE_MASK 0
#endif

#define LAS __attribute__((address_space(3)))
typedef unsigned short bf16_t;
typedef short bf16x8 __attribute__((ext_vector_type(8)));
typedef float f32x4 __attribute__((ext_vector_type(4)));
typedef unsigned u32x4 __attribute__((ext_vector_type(4)));
typedef unsigned u32x2 __attribute__((ext_vector_type(2)));

constexpr int T = 49152, LP = 16384, LSQ = 8192, DM = 1024, DIN = 2304, DFF = 2816, NLAYER = 4;
constexpr float EPS = 1e-6f;
constexpr int LDS_BYTES = 159744;
constexpr int NPHASE = 1 + 9 * NLAYER;

constexpr size_t GUARD = 256 * 2048;
constexpr size_t SZ_HB = (size_t)T * DM * 2;
constexpr size_t OFF_X = GUARD;
constexpr size_t OFF_Y = OFF_X + SZ_HB + GUARD;
constexpr size_t OFF_ZA = OFF_Y + SZ_HB + GUARD;
constexpr size_t SZ_ZA = (size_t)T * DFF * 2;
constexpr size_t OFF_V = OFF_ZA + SZ_ZA;
constexpr size_t SZ_V = (size_t)T * 512 * 2;
constexpr size_t OFF_W = OFF_V + SZ_V;
constexpr size_t W_LAYER = 13369344;
constexpr size_t SZ_W = 2 * W_LAYER * 2;
constexpr size_t OFF_SSI = OFF_W + SZ_W;
constexpr size_t SZ_SS = (size_t)T * 16 * 4;
constexpr size_t OFF_SSF = OFF_SSI + SZ_SS;
constexpr size_t WS_END = OFF_SSF + SZ_SS;
constexpr size_t WO_IN = 0, WO_OUT = 2359296, WO_UP = 3407872, WO_DOWN = 9175040, WO_GATE = 12058624, WO_PROJ = 13107200;

struct P {
    const float *xp, *xs, *pp, *ps;
    const float *rms_mix, *w_in, *q_norm, *k_norm, *sink, *w_short, *b_short, *fw1, *fb1, *ffr1, *fw2, *fb2, *ffr2, *fw3, *hbias, *nao, *nho, *w_out, *rms_ffn, *w_up, *w_ffconv, *b_ffconv, *w_down, *w_gate, *w_proj;
    float* out;
    bf16_t *X, *Y, *ZA, *V, *W;
    float *ss_in, *ss_ffn;
    int nseq; int seq[125];
};

typedef const __attribute__((address_space(4))) P* KP;

__device__ __forceinline__ unsigned pk2(float lo, float hi) { unsigned r; asm volatile("v_cvt_pk_bf16_f32 %0, %1, %2" : "=v"(r) : "v"(lo), "v"(hi)); return r; }
__device__ __forceinline__ float bflo(unsigned u) { return __uint_as_float(u << 16); }
__device__ __forceinline__ float bfhi(unsigned u) { return __uint_as_float(u & 0xffff0000u); }
__device__ __forceinline__ float2 twid(float turns) { return make_float2(__builtin_amdgcn_cosf(turns), __builtin_amdgcn_sinf(turns)); }
__device__ __forceinline__ float2 twid_precise(float turns) { float s_, c_; sincospif(2.0f * turns, &s_, &c_); return make_float2(c_, s_); }
__device__ __forceinline__ float frcp(float x) { return 1.0f / x; }
__device__ __forceinline__ float rcp_nr(float x) { const float y = __builtin_amdgcn_rcpf(x); return __builtin_fmaf(y, __builtin_fmaf(-x, y, 1.0f), y); }
__device__ __forceinline__ float bf1(bf16_t h) { return __uint_as_float(((unsigned)h) << 16); }
__device__ __forceinline__ int otid(int wv) { unsigned z = 0; asm volatile("" : "+v"(z)); int t = wv * 64 + (int)__builtin_amdgcn_mbcnt_hi(~0u, __builtin_amdgcn_mbcnt_lo(~0u, z)); asm volatile("" : "+v"(t)); return t; }
__device__ __forceinline__ int obid() { int b = blockIdx.x; asm volatile("" : "+s"(b)); return b; }
__device__ __forceinline__ int ogrid() { int g = gridDim.x; asm volatile("" : "+s"(g)); return g; }
__device__ __forceinline__ float shx(float v, int mask, int lane) { return __int_as_float(__builtin_amdgcn_ds_bpermute((lane ^ mask) << 2, __float_as_int(v))); }
__device__ __forceinline__ float wave_sum(float v, int lane) {
#pragma unroll
    for (int o = 32; o >= 1; o >>= 1) v += shx(v, o, lane);
    return v;
}
__device__ __forceinline__ void seq_of(int t, int& sbase, int& L) {
    if (t < LP) { sbase = 0; L = LP; } else { sbase = LP + ((t - LP) / LSQ) * LSQ; L = LSQ; }
}

__device__ __forceinline__ void ph_xconv(KP p, int wv) {
    const int tid0 = otid(wv), wid = tid0 >> 6, lane = tid0 & 63;
    for (int t = obid() * 8 + wid; t < T; t += ogrid() * 8) {
        const float* src = t < LP ? p->xp + (size_t)t * DM : p->xs + (size_t)(t - LP) * DM;
        float ss = 0.f;
#pragma unroll
        for (int i = 0; i < 4; ++i) {
            f32x4 v = *(const f32x4*)(src + i * 256 + lane * 4);
            ss += v.x * v.x + v.y * v.y + v.z * v.z + v.w * v.w;
            u32x2 o; o.x = pk2(v.x, v.y); o.y = pk2(v.z, v.w);
            *(u32x2*)(p->Y + (size_t)t * DM + i * 256 + lane * 4) = o;
        }
        ss = wave_sum(ss, lane);
        if (lane < 16) p->ss_in[(size_t)t * 16 + lane] = lane == 0 ? ss : 0.f;
    }
}

__device__ __forceinline__ void ph_wconv(KP p, int l, unsigned char* sm, int wv) {
    float* tl = (float*)sm;
    bf16_t* Wl = p->W + (size_t)(l & 1) * W_LAYER;
    const int tid = otid(wv);
    for (int g = obid(); g < 3264; g += ogrid()) {
        const float* src; const float* gain = nullptr; bf16_t* dst; int K, N, tile;
        if (g < 576) { src = p->w_in + (size_t)l * 1024 * 2304; gain = p->rms_mix + l * 1024; dst = Wl + WO_IN; K = 1024; N = 2304; tile = g; }
        else if (g < 832) { src = p->w_out + (size_t)l * 1024 * 1024; dst = Wl + WO_OUT; K = 1024; N = 1024; tile = g - 576; }
        else if (g < 2240) { src = p->w_up + (size_t)l * 1024 * 5632; gain = p->rms_ffn + l * 1024; dst = Wl + WO_UP; K = 1024; N = 5632; tile = g - 832; }
        else if (g < 2944) { src = p->w_down + (size_t)l * 2816 * 1024; dst = Wl + WO_DOWN; K = 2816; N = 1024; tile = g - 2240; }
        else if (g < 3200) { src = p->w_gate + (size_t)l * 1024 * 1024; dst = Wl + WO_GATE; K = 1024; N = 1024; tile = g - 2944; }
        else { src = p->w_proj + (size_t)l * 256 * 1024; dst = Wl + WO_PROJ; K = 256; N = 1024; tile = g - 3200; }
        const int ntn = N / 64, k0 = (tile / ntn) * 64, n0 = (tile % ntn) * 64;
        __syncthreads();
#pragma unroll
        for (int i = 0; i < 8; ++i) {
            const int r = (tid >> 6) + 8 * i, c = tid & 63;
            float v = src[(size_t)(k0 + r) * N + n0 + c];
            if (gain) v *= gain[k0 + r];
            tl[r * 65 + c] = v;
        }
        __syncthreads();
#pragma unroll
        for (int i = 0; i < 8; ++i) {
            const int r = (tid >> 6) + 8 * i, c = tid & 63;
            unsigned pk = pk2(tl[c * 65 + r], 0.f);
            dst[(size_t)(n0 + r) * K + k0 + c] = (bf16_t)(pk & 0xffffu);
        }
    }
}

__device__ __forceinline__ void ph_pconv(KP p, int l, int wv) {
    for (int i = obid() * 512 + otid(wv); i < T * 32; i += ogrid() * 512) {
        const int t = i >> 5, c8 = (i & 31) * 8;
        const float* src = t < LP ? p->pp + ((size_t)l * LP + t) * 256 + c8 : p->ps + ((size_t)l * 32768 + (t - LP)) * 256 + c8;
        f32x4 a = *(const f32x4*)src, b = *(const f32x4*)(src + 4);
        u32x4 o; o.x = pk2(a.x, a.y); o.y = pk2(a.z, a.w); o.z = pk2(b.x, b.y); o.w = pk2(b.z, b.w);
        *(u32x4*)(p->V + (size_t)t * 256 + c8) = o;
    }
}

constexpr int BM = 256, BK = 64, HALF = 128, HTB = HALF * BK * 2, NXCD = 8, WGM = 4;
__device__ __forceinline__ int lds_byte(int r, int c) { const int st = (r >> 4) * 2 + (c >> 5), rr = r & 15, cc = c & 31, ob = rr * 64 + cc * 2; return st * 1024 + (ob ^ (((ob >> 9) & 1) << 5)); }
__device__ __forceinline__ void stage_rc(int b, int& R, int& C) { const int st = b / 1024, sb = b % 1024, swz = sb ^ (((sb >> 9) & 1) << 5); R = (st >> 1) * 16 + swz / 64; C = (st & 1) * 32 + (swz % 64) / 2; }
__device__ __forceinline__ int perm32(int rho) { const int n = rho >> 4, i = rho & 15; return 8 * (i >> 2) + 4 * n + (i & 3); }

struct Unit { int pm, pn; long arow; int b0, b1; };
struct Sched {
    int nM, nN, nwg, G, c, mode;
    __device__ __forceinline__ void init(int nM_, int nN_, int mode_) { nM = nM_; nN = nN_; nwg = nM * nN; G = ogrid(); c = obid(); mode = mode_; }
    __device__ __forceinline__ bool next(int i, Unit& u) const {
        const long Lx = (long)i * G + c; if (Lx >= nwg) return false;
        int wgid = (int)Lx; { const int q = nwg / NXCD, r = nwg % NXCD, xcd = wgid % NXCD, off = wgid / NXCD; wgid = (xcd < r ? xcd * (q + 1) : r * (q + 1) + (xcd - r) * q) + off; }
        const int nig = WGM * nN, gid = wgid / nig, fm = gid * WGM, gsz = (nM - fm) < WGM ? (nM - fm) : WGM;
        u.pm = fm + ((wgid % nig) % gsz); u.pn = (wgid % nig) / gsz;
        if (mode == 0) { u.arow = (long)u.pm * 256; u.b0 = u.pn * 256; u.b1 = u.pn * 256 + 128; }
        else {
            int sb, i2; if (u.pm < 65) { sb = 0; i2 = u.pm; } else { const int r = u.pm - 65; sb = LP + (r / 33) * LSQ; i2 = r % 33; }
            u.arow = (long)sb + 254 * i2 - 1; u.b0 = u.pn * 128; u.b1 = DFF + u.pn * 128;
        }
        return true;
    }
};

template <class Epi>
__device__ __forceinline__ void gemm_phase(LAS unsigned char* lds, const bf16_t* Ag, const bf16_t* Btg, const int K, const Sched& S, const Epi& E, int wv) {
    const int tid = otid(wv), wid = __builtin_amdgcn_readfirstlane(tid >> 6), lane = tid & 63, wr = wid >> 2, wc = wid & 3, fr = lane & 15, fq = lane >> 4;
    const int nt = K / BK;
    unsigned voffA[2], voffB[2];
#pragma unroll
    for (int i = 0; i < 2; ++i) { int R, C; stage_rc(tid * 16 + i * 8192, R, C); const int Rb = (R & ~31) + perm32(R & 31);
        voffA[i] = (unsigned)(R * K + C) * 2u; voffB[i] = (unsigned)(Rb * K + C) * 2u; }
    const size_t kstep = (size_t)(BK * 2);
    const size_t hstep = (size_t)HALF * K * 2;
    const size_t rowb = (size_t)K * 2;
    const unsigned ldsw = (unsigned)wid * 1024u;
    const int aoff = lds_byte(wr * 64 + fr, fq * 8), boff = lds_byte(wc * 32 + fr, fq * 8);
#define G_SA(b, h) (((b) * 2 + (h)) * HTB)
#define G_SB(b, h) ((4 + (b) * 2 + (h)) * HTB)
#define G_STAGE(bufoff, gbase, voff) do { const char* _gb = (const char*)(gbase); asm volatile("" : "+s"(_gb)); _Pragma("unroll") for (int _i = 0; _i < 2; ++_i) \
        __builtin_amdgcn_global_load_lds((const unsigned*)(_gb + (voff)[_i]), (LAS unsigned*)(lds + (bufoff) + ldsw + _i * 8192), 16, 0, 0); } while (0)
#define G_LDA(dst, b, h) do { _Pragma("unroll") for (int m = 0; m < 4; ++m) _Pragma("unroll") for (int k = 0; k < 2; ++k) dst[m][k] = *(const LAS bf16x8*)(lds + G_SA(b, h) + aoff + m * 2048 + k * 1024); } while (0)
#define G_LDB(dst, b, h) do { _Pragma("unroll") for (int n = 0; n < 2; ++n) _Pragma("unroll") for (int k = 0; k < 2; ++k) dst[n][k] = *(const LAS bf16x8*)(lds + G_SB(b, h) + boff + n * 2048 + k * 1024); } while (0)
#define G_MMA(ai, bj, At, Bt) do { __builtin_amdgcn_s_setprio(1); _Pragma("unroll") for (int m = 0; m < 4; ++m) _Pragma("unroll") for (int n = 0; n < 2; ++n) _Pragma("unroll") for (int k = 0; k < 2; ++k) \
        acc[ai][bj][m][n] = __builtin_amdgcn_mfma_f32_16x16x32_bf16(Bt[n][k], At[m][k], acc[ai][bj][m][n], 0, 0, 0); __builtin_amdgcn_s_setprio(0); } while (0)
#define G_WAIT_V(n) asm volatile("s_waitcnt vmcnt(" #n ")" ::: "memory")
#define G_WAIT_L(n) asm volatile("s_waitcnt lgkmcnt(" #n ")" ::: "memory")
#define G_BAR __builtin_amdgcn_s_barrier()
#define G_SCHED __builtin_amdgcn_sched_barrier(0)
    Unit cur, nxt; int ui = 0;
    if (!S.next(0, cur)) return;
    f32x4 acc[2][2][4][2];
#pragma unroll
    for (int a = 0; a < 2; ++a)
#pragma unroll
        for (int b = 0; b < 2; ++b)
#pragma unroll
            for (int m = 0; m < 4; ++m)
#pragma unroll
                for (int n = 0; n < 2; ++n) acc[a][b][m][n] = (f32x4){0.f, 0.f, 0.f, 0.f};
    bf16x8 At[4][2], B0[2][2], B1[2][2];
    const char* cA = (const char*)Ag + cur.arow * (long)rowb;
    const char* cB0 = (const char*)Btg + (size_t)cur.b0 * rowb;
    const char* cB1 = (const char*)Btg + (size_t)cur.b1 * rowb;
    G_STAGE(G_SB(0, 0), cB0, voffB); G_STAGE(G_SA(0, 0), cA, voffA); G_STAGE(G_SB(0, 1), cB1, voffB); G_STAGE(G_SA(0, 1), cA + hstep, voffA);
    if (wr == 1) G_BAR;
    G_WAIT_V(4); G_BAR;
    G_STAGE(G_SB(1, 0), cB0 + kstep, voffB); G_STAGE(G_SA(1, 0), cA + kstep, voffA); G_STAGE(G_SB(1, 1), cB1 + kstep, voffB);
    G_WAIT_V(6); G_BAR;
    for (;;) {
        const bool has_next = S.next(ui + 1, nxt);
        const char* nA = has_next ? (const char*)Ag + nxt.arow * (long)rowb : cA;
        const char* nB0 = has_next ? (const char*)Btg + (size_t)nxt.b0 * rowb : cB0;
        const char* nB1 = has_next ? (const char*)Btg + (size_t)nxt.b1 * rowb : cB1;
        for (int t = 0; t < nt; t += 2) {
            const bool last = (t == nt - 2);
            const char* a1 = cA + (size_t)(t + 1) * kstep;
            const char* a2 = last ? nA : cA + (size_t)(t + 2) * kstep;
            const char* b20 = last ? nB0 : cB0 + (size_t)(t + 2) * kstep;
            const char* b21 = last ? nB1 : cB1 + (size_t)(t + 2) * kstep;
            const char* a3 = a2 + kstep; const char* b30 = b20 + kstep; const char* b31 = b21 + kstep;
            G_LDB(B0, 0, 0); G_SCHED; G_LDA(At, 0, 0); G_STAGE(G_SA(1, 1), a1 + hstep, voffA);
            G_WAIT_L(8); G_BAR; G_WAIT_L(0); G_MMA(0, 0, At, B0); G_BAR; G_SCHED;
            G_LDB(B1, 0, 1); G_STAGE(G_SB(0, 0), b20, voffB);
            G_BAR; G_WAIT_L(0); G_MMA(0, 1, At, B1); G_BAR;
            G_LDA(At, 0, 1); G_STAGE(G_SA(0, 0), a2, voffA);
            G_BAR; G_WAIT_L(0); G_MMA(1, 0, At, B0); G_BAR; G_SCHED;
            G_STAGE(G_SB(0, 1), b21, voffB);
            G_WAIT_V(6); G_BAR; G_MMA(1, 1, At, B1); G_BAR;
            G_LDB(B0, 1, 0); G_SCHED; G_LDA(At, 1, 0); G_STAGE(G_SA(0, 1), a2 + hstep, voffA);
            G_WAIT_L(8); G_BAR; G_WAIT_L(0); G_MMA(0, 0, At, B0); G_BAR; G_SCHED;
            G_LDB(B1, 1, 1); G_STAGE(G_SB(1, 0), b30, voffB);
            G_BAR; G_WAIT_L(0); G_MMA(0, 1, At, B1); G_BAR;
            G_LDA(At, 1, 1); G_STAGE(G_SA(1, 0), a3, voffA);
            G_BAR; G_WAIT_L(0); G_MMA(1, 0, At, B0); G_BAR; G_SCHED;
            G_STAGE(G_SB(1, 1), b31, voffB);
            G_WAIT_V(6); G_BAR; G_MMA(1, 1, At, B1); G_BAR;
        }
        E(acc, cur, wr, wc, fr, fq, lds);
        if (!has_next) break;
#pragma unroll
        for (int a = 0; a < 2; ++a)
#pragma unroll
            for (int b = 0; b < 2; ++b)
#pragma unroll
                for (int m = 0; m < 4; ++m)
#pragma unroll
                    for (int n = 0; n < 2; ++n) acc[a][b][m][n] = (f32x4){0.f, 0.f, 0.f, 0.f};
        cur = nxt; cA = nA; cB0 = nB0; cB1 = nB1; ++ui;
    }
    G_WAIT_V(0);
    if (wr == 0) G_BAR;
    G_BAR;
#undef G_SA
#undef G_SB
#undef G_STAGE
#undef G_LDA
#undef G_LDB
#undef G_MMA
}

constexpr int EPI_XB = 131072, EPI_RS = 131072 + 4096, EPI_CW = 131072 + 5120;
__device__ __forceinline__ void stage_rstd(LAS unsigned char* lds, const float* ss, int tid, long grow0, int sr0, int L) {
    if (tid < 256) {
        const int sr = sr0 + tid; const bool valid = sr >= 0 && sr < L;
        const f32x4* q = (const f32x4*)(ss + (size_t)(valid ? grow0 + tid : 0) * 16);
        const f32x4 a = q[0], b = q[1], c = q[2], d = q[3];
        const float sm_ = ((a.x + a.y) + (a.z + a.w)) + ((b.x + b.y) + (b.z + b.w)) + ((c.x + c.y) + (c.z + c.w)) + ((d.x + d.y) + (d.z + d.w));
        ((LAS float*)(lds + EPI_RS))[tid] = valid ? rsqrtf(sm_ * (1.0f / 1024.0f) + EPS) : 0.f;
    }
}
#define EPI_SYNC() do { asm volatile("s_waitcnt lgkmcnt(0)" ::: "memory"); __builtin_amdgcn_s_barrier(); __builtin_amdgcn_s_barrier(); asm volatile("" ::: "memory"); } while (0)

struct EpiIn {
    bf16_t* Z; const float* ss;
    __device__ __forceinline__ void operator()(f32x4 (&acc)[2][2][4][2], const Unit& u, int wr, int wc, int fr, int fq, LAS unsigned char* lds) const {
        asm volatile("" : "+v"(fr), "+v"(fq), "+s"(wr), "+s"(wc));
        const int tid = (wr * 4 + wc) * 64 + fq * 16 + fr;
        stage_rstd(lds, ss, tid, (long)u.pm * 256, 0, 1 << 30);
        EPI_SYNC();
        const LAS float* rs = (const LAS float*)(lds + EPI_RS);
        const int row0 = u.pm * 256 + wr * 64 + fr, col0 = wc * 32 + 8 * fq;
#pragma unroll
        for (int ai = 0; ai < 2; ++ai)
#pragma unroll
            for (int m = 0; m < 4; ++m) {
                const int row = row0 + ai * 128 + m * 16; const float r = rs[128 * ai + 64 * wr + 16 * m + fr];
#pragma unroll
                for (int bj = 0; bj < 2; ++bj) {
                    const f32x4 v0 = acc[ai][bj][m][0] * r, v1 = acc[ai][bj][m][1] * r;
                    u32x4 o; o.x = pk2(v0.x, v0.y); o.y = pk2(v0.z, v0.w); o.z = pk2(v1.x, v1.y); o.w = pk2(v1.z, v1.w);
                    *(u32x4*)(Z + (size_t)row * DIN + (bj ? u.b1 : u.b0) + col0) = o;
                }
            }
    }
};
struct EpiRes {
    const float* xp; const float* xs; const bf16_t* rsrc; bf16_t* hb; float* ss; int mode;
    __device__ __forceinline__ void operator()(f32x4 (&acc)[2][2][4][2], const Unit& u, int wr, int wc, int fr, int fq, LAS unsigned char*) const {
        asm volatile("" : "+v"(fr), "+v"(fq), "+s"(wr), "+s"(wc));
        const int row0 = u.pm * 256 + wr * 64 + fr, col0 = wc * 32 + 8 * fq;
#pragma unroll
        for (int ai = 0; ai < 2; ++ai) {
            __builtin_amdgcn_sched_barrier(0);
            f32x4 rv[4][2][2];
            if (mode == 0) {
#pragma unroll
                for (int m = 0; m < 4; ++m) {
                    const int row = row0 + ai * 128 + m * 16;
                    const float* rp = row < LP ? xp + (size_t)row * DM : xs + (size_t)(row - LP) * DM;
#pragma unroll
                    for (int bj = 0; bj < 2; ++bj) { const int col = (bj ? u.b1 : u.b0) + col0; rv[m][bj][0] = *(const f32x4*)(rp + col); rv[m][bj][1] = *(const f32x4*)(rp + col + 4); }
                }
            } else {
                u32x4 rb[4][2];
#pragma unroll
                for (int m = 0; m < 4; ++m)
#pragma unroll
                    for (int bj = 0; bj < 2; ++bj) rb[m][bj] = *(const u32x4*)(rsrc + (size_t)(row0 + ai * 128 + m * 16) * DM + (bj ? u.b1 : u.b0) + col0);
#pragma unroll
                for (int m = 0; m < 4; ++m)
#pragma unroll
                    for (int bj = 0; bj < 2; ++bj) {
                        const u32x4 q = rb[m][bj];
                        rv[m][bj][0] = (f32x4){bflo(q.x), bfhi(q.x), bflo(q.y), bfhi(q.y)}; rv[m][bj][1] = (f32x4){bflo(q.z), bfhi(q.z), bflo(q.w), bfhi(q.w)};
                    }
            }
            __builtin_amdgcn_sched_barrier(0);
#pragma unroll
            for (int m = 0; m < 4; ++m) {
                const int row = row0 + ai * 128 + m * 16;
                float sq = 0.f;
#pragma unroll
                for (int bj = 0; bj < 2; ++bj) {
                    const int col = (bj ? u.b1 : u.b0) + col0;
                    const f32x4 h0 = rv[m][bj][0] + acc[ai][bj][m][0], h1 = rv[m][bj][1] + acc[ai][bj][m][1];
                    sq += h0.x * h0.x + h0.y * h0.y + h0.z * h0.z + h0.w * h0.w + h1.x * h1.x + h1.y * h1.y + h1.z * h1.z + h1.w * h1.w;
                    u32x4 o; o.x = pk2(h0.x, h0.y); o.y = pk2(h0.z, h0.w); o.z = pk2(h1.x, h1.y); o.w = pk2(h1.z, h1.w);
                    *(u32x4*)(hb + (size_t)row * DM + col) = o;
                }
                if (ss) { sq += shx(sq, 16, fq * 16 + fr); sq += shx(sq, 32, fq * 16 + fr); if (fq == 0) ss[(size_t)row * 16 + u.pn * 4 + wc] = sq; }
            }
        }
    }
};
struct EpiGate {
    bf16_t* Sg;
    __device__ __forceinline__ void operator()(f32x4 (&acc)[2][2][4][2], const Unit& u, int wr, int wc, int fr, int fq, LAS unsigned char*) const {
        asm volatile("" : "+v"(fr), "+v"(fq), "+s"(wr), "+s"(wc));
        const int row0 = u.pm * 256 + wr * 64 + fr, col0 = wc * 32 + 8 * fq;
#pragma unroll
        for (int ai = 0; ai < 2; ++ai)
#pragma unroll
            for (int m = 0; m < 4; ++m) {
                __builtin_amdgcn_sched_barrier(0); const int row = row0 + ai * 128 + m * 16;
#pragma unroll
                for (int bj = 0; bj < 2; ++bj) {
                    float s[8];
#pragma unroll
                    for (int n = 0; n < 2; ++n)
#pragma unroll
                        for (int j = 0; j < 4; ++j) s[n * 4 + j] = frcp(1.0f + __expf(-acc[ai][bj][m][n][j]));
                    u32x4 o; o.x = pk2(s[0], s[1]); o.y = pk2(s[2], s[3]); o.z = pk2(s[4], s[5]); o.w = pk2(s[6], s[7]);
                    *(u32x4*)(Sg + (size_t)row * DM + (bj ? u.b1 : u.b0) + col0) = o;
                }
            }
    }
};
struct EpiProj {
    const bf16_t* Sg; const bf16_t* hbx; float* out; bf16_t* hb; float* ss; int last;
    __device__ __forceinline__ void operator()(f32x4 (&acc)[2][2][4][2], const Unit& u, int wr, int wc, int fr, int fq, LAS unsigned char*) const {
        asm volatile("" : "+v"(fr), "+v"(fq), "+s"(wr), "+s"(wc));
        const int row0 = u.pm * 256 + wr * 64 + fr, col0 = wc * 32 + 8 * fq;
#pragma unroll
        for (int ai = 0; ai < 2; ++ai)
#pragma unroll
            for (int mp = 0; mp < 2; ++mp) {
                __builtin_amdgcn_sched_barrier(0);
                u32x4 sgv[2][2], ovb[2][2]; f32x4 ov[2][2][2];
#pragma unroll
                for (int mm = 0; mm < 2; ++mm) {
                    const int row = row0 + ai * 128 + (mp * 2 + mm) * 16;
#pragma unroll
                    for (int bj = 0; bj < 2; ++bj) {
                        const int col = (bj ? u.b1 : u.b0) + col0;
                        sgv[mm][bj] = *(const u32x4*)(Sg + (size_t)row * DM + col);
                        ovb[mm][bj] = *(const u32x4*)(hbx + (size_t)row * DM + col);
                    }
                }
                __builtin_amdgcn_sched_barrier(0);
#pragma unroll
                for (int mm = 0; mm < 2; ++mm)
#pragma unroll
                    for (int bj = 0; bj < 2; ++bj) {
                        const u32x4 q = ovb[mm][bj];
                        ov[mm][bj][0] = (f32x4){bflo(q.x), bfhi(q.x), bflo(q.y), bfhi(q.y)}; ov[mm][bj][1] = (f32x4){bflo(q.z), bfhi(q.z), bflo(q.w), bfhi(q.w)};
                    }
#pragma unroll
                for (int mm = 0; mm < 2; ++mm) {
                    const int m = mp * 2 + mm, row = row0 + ai * 128 + m * 16;
                    float sq = 0.f;
#pragma unroll
                    for (int bj = 0; bj < 2; ++bj) {
                        const int col = (bj ? u.b1 : u.b0) + col0;
                        const u32x4 sg = sgv[mm][bj];
                        f32x4 g0, g1; g0.x = bflo(sg.x); g0.y = bfhi(sg.x); g0.z = bflo(sg.y); g0.w = bfhi(sg.y); g1.x = bflo(sg.z); g1.y = bfhi(sg.z); g1.z = bflo(sg.w); g1.w = bfhi(sg.w);
                        const f32x4 h0 = ov[mm][bj][0] + g0 * acc[ai][bj][m][0], h1 = ov[mm][bj][1] + g1 * acc[ai][bj][m][1];
                        if (last) { float* op = out + (size_t)row * DM + col; *(f32x4*)op = h0; *(f32x4*)(op + 4) = h1; }
                        sq += h0.x * h0.x + h0.y * h0.y + h0.z * h0.z + h0.w * h0.w + h1.x * h1.x + h1.y * h1.y + h1.z * h1.z + h1.w * h1.w;
                        if (!last) { u32x4 o; o.x = pk2(h0.x, h0.y); o.y = pk2(h0.z, h0.w); o.z = pk2(h1.x, h1.y); o.w = pk2(h1.z, h1.w); *(u32x4*)(hb + (size_t)row * DM + col) = o; }
                    }
                    sq += shx(sq, 16, fq * 16 + fr); sq += shx(sq, 32, fq * 16 + fr); if (fq == 0 && !last) ss[(size_t)row * 16 + u.pn * 4 + wc] = sq;
                }
            }
    }
};
__device__ __forceinline__ unsigned dppu_ror1(unsigned x) { return (unsigned)__builtin_amdgcn_update_dpp(0, (int)x, 0x121, 0xf, 0xf, false); }
__device__ __forceinline__ unsigned dppu_ror15(unsigned x) { return (unsigned)__builtin_amdgcn_update_dpp(0, (int)x, 0x12F, 0xf, 0xf, false); }
struct EpiUp {
    bf16_t* act; const float* ss; const float* w3; const float* b3;
    __device__ __forceinline__ void operator()(f32x4 (&acc)[2][2][4][2], const Unit& u, int wr, int wc, int fr, int fq, LAS unsigned char* lds) const {
        asm volatile("" : "+v"(fr), "+v"(fq), "+s"(wr), "+s"(wc));
        int sb, L, i2; if (u.pm < 65) { sb = 0; L = LP; i2 = u.pm; } else { const int r = u.pm - 65; sb = LP + (r / 33) * LSQ; L = LSQ; i2 = r % 33; }
        const int sr0 = 254 * i2 - 1;
        const int tid = (wr * 4 + wc) * 64 + fq * 16 + fr;
        stage_rstd(lds, ss, tid, (long)sb + sr0, sr0, L);
        {
            LAS float* cw = (LAS float*)(lds + EPI_CW);
#pragma unroll
            for (int i = 0; i < 2; ++i) {
                const int e = tid + 512 * i, bj = e >> 9, k = (e >> 7) & 3, c = e & 127;
                cw[e] = k < 3 ? w3[k * 2 * DFF + bj * DFF + u.b0 + c] : b3[bj * DFF + u.b0 + c];
            }
        }
        EPI_SYNC();
        const LAS float* rs = (const LAS float*)(lds + EPI_RS);
        unsigned pq[2][2][4][2][2];
#pragma unroll
        for (int ai = 0; ai < 2; ++ai)
#pragma unroll
            for (int m = 0; m < 4; ++m) {
                const float r = rs[128 * ai + 64 * wr + 16 * m + fr];
#pragma unroll
                for (int bj = 0; bj < 2; ++bj)
#pragma unroll
                    for (int n = 0; n < 2; ++n) {
                        const f32x4 v = acc[ai][bj][m][n];
                        pq[ai][bj][m][n][0] = r != 0.f ? pk2(v.x * r, v.y * r) : 0u;
                        pq[ai][bj][m][n][1] = r != 0.f ? pk2(v.z * r, v.w * r) : 0u;
                    }
            }
        LAS unsigned* xb = (LAS unsigned*)(lds + EPI_XB);
        const int clp = 16 * wc + 4 * fq;
        if (fr == 0) {
#pragma unroll
            for (int ai = 0; ai < 2; ++ai)
#pragma unroll
                for (int bj = 0; bj < 2; ++bj)
#pragma unroll
                    for (int n = 0; n < 2; ++n) { u32x2 t; t.x = pq[ai][bj][0][n][0]; t.y = pq[ai][bj][0][n][1]; *(LAS u32x2*)(xb + ((ai * 2 + wr) * 2 + 0) * 128 + 64 * bj + clp + 2 * n) = t; }
        }
        if (fr == 15) {
#pragma unroll
            for (int ai = 0; ai < 2; ++ai)
#pragma unroll
                for (int bj = 0; bj < 2; ++bj)
#pragma unroll
                    for (int n = 0; n < 2; ++n) { u32x2 t; t.x = pq[ai][bj][3][n][0]; t.y = pq[ai][bj][3][n][1]; *(LAS u32x2*)(xb + ((ai * 2 + wr) * 2 + 1) * 128 + 64 * bj + clp + 2 * n) = t; }
        }
        EPI_SYNC();
        constexpr bool r1prev = true;
        const int cl = 32 * wc + 8 * fq;
#pragma unroll
        for (int ai = 0; ai < 2; ++ai) {
            const int pa = wr ? ai : ai - 1, pw = wr ? 0 : 1, na = wr ? ai + 1 : ai, nw = wr ? 0 : 1;
            const bool hasp = pa >= 0 && fr == 0, hasn = na < 2 && fr == 15;
            unsigned outp[4][4];
#pragma unroll
            for (int n = 0; n < 2; ++n) {
                const LAS unsigned* xp_ = xb + (((pa < 0 ? 0 : pa) * 2 + pw) * 2 + 1) * 128 + clp + 2 * n;
                const LAS unsigned* xn_ = xb + (((na > 1 ? 1 : na) * 2 + nw) * 2 + 0) * 128 + clp + 2 * n;
#pragma unroll
                for (int jp = 0; jp < 2; ++jp) {
                    __builtin_amdgcn_sched_barrier(0);
                    float ag[2][4][2];
#pragma unroll
                    for (int bj = 0; bj < 2; ++bj) {
                        const LAS float* cwp = (const LAS float*)(lds + EPI_CW) + bj * 512 + cl + 4 * n + 2 * jp;
                        const float w0a = cwp[0], w0b = cwp[1], w1a = cwp[128], w1b = cwp[129], w2a = cwp[256], w2b = cwp[257], bba = cwp[384], bbb = cwp[385];
                        const unsigned hpv = hasp ? xp_[64 * bj + jp] : 0u, hnv = hasn ? xn_[64 * bj + jp] : 0u;
                        unsigned cv[4], ra[4], rb[4];
#pragma unroll
                        for (int m = 0; m < 4; ++m) { cv[m] = pq[ai][bj][m][n][jp]; const unsigned x1 = dppu_ror1(cv[m]), x15 = dppu_ror15(cv[m]); ra[m] = r1prev ? x1 : x15; rb[m] = r1prev ? x15 : x1; }
#pragma unroll
                        for (int m = 0; m < 4; ++m) {
                            const unsigned pv = fr > 0 ? ra[m] : (m > 0 ? ra[m > 0 ? m - 1 : 0] : hpv);
                            const unsigned nv = fr < 15 ? rb[m] : (m < 3 ? rb[m < 3 ? m + 1 : 3] : hnv);
                            ag[bj][m][0] = w0a * bflo(pv) + w1a * bflo(cv[m]) + w2a * bflo(nv) + bba;
                            ag[bj][m][1] = w0b * bfhi(pv) + w1b * bfhi(cv[m]) + w2b * bfhi(nv) + bbb;
                        }
                    }
#pragma unroll
                    for (int m = 0; m < 4; ++m) {
                        const float r0 = ag[0][m][0] * ag[1][m][0] * rcp_nr(1.0f + fminf(__expf(-ag[1][m][0]), 1e30f)), r1 = ag[0][m][1] * ag[1][m][1] * rcp_nr(1.0f + fminf(__expf(-ag[1][m][1]), 1e30f));
                        outp[m][2 * n + jp] = pk2(r0, r1);
                    }
                }
            }
#pragma unroll
            for (int m = 0; m < 4; ++m) {
                const int rt = 128 * ai + 64 * wr + 16 * m + fr, sr = sr0 + rt;
                if (rt >= 1 && rt <= 254 && sr < L) { u32x4 o; o.x = outp[m][0]; o.y = outp[m][1]; o.z = outp[m][2]; o.w = outp[m][3]; *(u32x4*)(act + (size_t)(sb + sr) * DFF + u.b0 + cl) = o; }
            }
        }
    }
};

__device__ __forceinline__ void unpack16(const u32x4& a, const u32x4& b, float (&x)[16]) {
    x[0] = bflo(a.x); x[1] = bfhi(a.x); x[2] = bflo(a.y); x[3] = bfhi(a.y); x[4] = bflo(a.z); x[5] = bfhi(a.z); x[6] = bflo(a.w); x[7] = bfhi(a.w);
    x[8] = bflo(b.x); x[9] = bfhi(b.x); x[10] = bflo(b.y); x[11] = bfhi(b.y); x[12] = bflo(b.z); x[13] = bfhi(b.z); x[14] = bflo(b.w); x[15] = bfhi(b.w);
}
__device__ __forceinline__ void qk_prep_store(u32x4 a, u32x4 b, const float* gain, int sub, int pos, float scale, bf16_t* dst, int lane) {
    float x[16]; unpack16(a, b, x);
    float ss = 0.f;
#pragma unroll
    for (int i = 0; i < 16; ++i) ss += x[i] * x[i];
    ss += shx(ss, 1, lane); ss += shx(ss, 2, lane);
    const float r = rsqrtf(ss * (1.0f / 64.0f) + EPS);
#pragma unroll
    for (int i = 0; i < 16; ++i) x[i] = x[i] * r * gain[sub * 16 + i];
    if (sub == 0) {
        const float ihi[8] = {(float)(1.0 / 3.14159265358979323846), (float)(0.19392274474868576 / 3.14159265358979323846), (float)(0.03760603093086393 / 3.14159265358979323846), (float)(0.007292664737217109 / 3.14159265358979323846),
                              (float)(0.001414213562373095 / 3.14159265358979323846), (float)(0.0002742481756762073 / 3.14159265358979323846), (float)(5.318295896944988e-05 / 3.14159265358979323846), (float)(1.031338537721246e-05 / 3.14159265358979323846)};
        const float ilo[8] = {(float)(1.0 / 3.14159265358979323846 - (double)(float)(1.0 / 3.14159265358979323846)), (float)(0.19392274474868576 / 3.14159265358979323846 - (double)(float)(0.19392274474868576 / 3.14159265358979323846)),
                              (float)(0.03760603093086393 / 3.14159265358979323846 - (double)(float)(0.03760603093086393 / 3.14159265358979323846)), (float)(0.007292664737217109 / 3.14159265358979323846 - (double)(float)(0.007292664737217109 / 3.14159265358979323846)),
                              (float)(0.001414213562373095 / 3.14159265358979323846 - (double)(float)(0.001414213562373095 / 3.14159265358979323846)), (float)(0.0002742481756762073 / 3.14159265358979323846 - (double)(float)(0.0002742481756762073 / 3.14159265358979323846)),
                              (float)(5.318295896944988e-05 / 3.14159265358979323846 - (double)(float)(5.318295896944988e-05 / 3.14159265358979323846)), (float)(1.031338537721246e-05 / 3.14159265358979323846 - (double)(float)(1.031338537721246e-05 / 3.14159265358979323846))};
#pragma unroll
        for (int j = 0; j < 8; ++j) {
            const float fp = (float)pos, ph = fp * ihi[j], pe = __builtin_fmaf(fp, ihi[j], -ph) + fp * ilo[j];
            const float red = (ph - 2.0f * rintf(0.5f * ph)) + pe;
            const float2 cs = twid_precise(0.5f * red); const float c = cs.x, s = cs.y;
            const float x1 = x[j], x2 = x[8 + j];
            x[j] = x1 * c - x2 * s; x[8 + j] = x2 * c + x1 * s;
        }
    }
    u32x4 o0, o1;
    o0.x = pk2(x[0] * scale, x[1] * scale); o0.y = pk2(x[2] * scale, x[3] * scale); o0.z = pk2(x[4] * scale, x[5] * scale); o0.w = pk2(x[6] * scale, x[7] * scale);
    o1.x = pk2(x[8] * scale, x[9] * scale); o1.y = pk2(x[10] * scale, x[11] * scale); o1.z = pk2(x[12] * scale, x[13] * scale); o1.w = pk2(x[14] * scale, x[15] * scale);
    *(u32x4*)dst = o0; *(u32x4*)(dst + 8) = o1;
}

__device__ __forceinline__ void ph_attn(KP p, int l, unsigned char* sm, int wv) {
    bf16_t* Ks = (bf16_t*)sm;
    bf16_t* Vt = (bf16_t*)(sm + 57600);
    bf16_t* Qs = (bf16_t*)(sm + 57600 + 51712);
    const bf16_t* Z = p->ZA;
    const int tid = otid(wv), wid = tid >> 6, lane = tid & 63, fr = lane & 15, fq = lane >> 4;
    const float* qg = p->q_norm + l * 64; const float* kg = p->k_norm + l * 64;
    for (int item0 = obid(); item0 < 768; item0 += ogrid()) {
        const int item = ogrid() == 256 ? (item0 & 7) * 96 + (item0 >> 8) * 32 + ((item0 & 255) >> 3) : item0;
        const int kvh = item / 384, qb = item - kvh * 384, Q0 = qb * 128;
        int sbase, L; seq_of(Q0, sbase, L);
        const int Q0rel = Q0 - sbase;
        const bool interior = Q0rel >= 128 && Q0rel + 256 <= L;
        __syncthreads();
        {
            u32x4 ka[4], kb[4], va[4], vb[4];
#pragma unroll
            for (int it = 0; it < 4; ++it) {
                const int idx = tid + 512 * it, row = idx >> 2, sub = idx & 3, prel = Q0rel - 128 + row;
                const bool inb = idx < 1600 && row < 384 && prel >= 0 && prel < L;
                ka[it] = (u32x4){0u, 0u, 0u, 0u}; kb[it] = ka[it]; va[it] = ka[it]; vb[it] = ka[it];
                if (inb) {
                    const bf16_t* src = Z + (size_t)(sbase + prel) * DIN + 512 + kvh * 64 + sub * 16;
                    ka[it] = *(const u32x4*)src; kb[it] = *(const u32x4*)(src + 8);
                    va[it] = *(const u32x4*)(src + 128); vb[it] = *(const u32x4*)(src + 136);
                }
            }
#pragma unroll
            for (int it = 0; it < 4; ++it) {
                const int idx = tid + 512 * it, row = idx >> 2, sub = idx & 3, prel = Q0rel - 128 + row;
                if (idx < 1600) {
                    qk_prep_store(ka[it], kb[it], kg, sub, prel, 1.0f, Ks + row * 72 + sub * 16, lane);
                    const unsigned vv[8] = {va[it].x, va[it].y, va[it].z, va[it].w, vb[it].x, vb[it].y, vb[it].z, vb[it].w};
#pragma unroll
                    for (int i = 0; i < 8; ++i) {
                        Vt[(sub * 16 + 2 * i) * 404 + row] = (bf16_t)(vv[i] & 0xffffu);
                        Vt[(sub * 16 + 2 * i + 1) * 404 + row] = (bf16_t)(vv[i] >> 16);
                    }
                }
            }
        }
        u32x4 qa[4], qb2[4];
#pragma unroll
        for (int g = 0; g < 4; ++g) {
            const bf16_t* src = Z + (size_t)(Q0 + (tid >> 2)) * DIN + (kvh * 4 + g) * 64 + (tid & 3) * 16;
            qa[g] = *(const u32x4*)src; qb2[g] = *(const u32x4*)(src + 8);
        }
        for (int g = 0; g < 4; ++g) {
            const int h = kvh * 4 + g;
            __syncthreads();
            {
                const int row = tid >> 2, sub = tid & 3;
                const u32x4 qsa = g == 0 ? qa[0] : (g == 1 ? qa[1] : (g == 2 ? qa[2] : qa[3])), qsb = g == 0 ? qb2[0] : (g == 1 ? qb2[1] : (g == 2 ? qb2[2] : qb2[3]));
                qk_prep_store(qsa, qsb, qg, sub, Q0rel + row, 0.125f * 1.4426950408889634f, Qs + row * 72 + sub * 16, lane);
            }
            __syncthreads();
            bf16x8 qf[2];
#pragma unroll
            for (int ks = 0; ks < 2; ++ks) qf[ks] = *(const bf16x8*)(Qs + (16 * wid + fr) * 72 + 32 * ks + 8 * fq);
            f32x4 o[4];
#pragma unroll
            for (int dt = 0; dt < 4; ++dt) o[dt] = (f32x4){0.f, 0.f, 0.f, 0.f};
            float mrun = p->sink[l * 8 + h] * 1.4426950408889634f;
            float lsum = fq == 0 ? 1.0f : 0.0f;
            const int qi = 16 * wid + fr;
            for (int s = 0; s < 9; ++s) {
                const int kk0 = 16 * wid + 32 * s;
                f32x4 st[2];
#pragma unroll
                for (int kt = 0; kt < 2; ++kt) {
                    st[kt] = (f32x4){0.f, 0.f, 0.f, 0.f};
#pragma unroll
                    for (int ks = 0; ks < 2; ++ks) {
                        const bf16x8 kf = *(const bf16x8*)(Ks + (kk0 + 16 * kt + fr) * 72 + 32 * ks + 8 * fq);
                        st[kt] = __builtin_amdgcn_mfma_f32_16x16x32_bf16(kf, qf[ks], st[kt], 0, 0, 0);
                    }
                }
                float sv[2][4]; float mx = -1e30f;
                if (interior && s >= 1 && s <= 7) {
#pragma unroll
                    for (int kt = 0; kt < 2; ++kt)
#pragma unroll
                        for (int r = 0; r < 4; ++r) { sv[kt][r] = st[kt][r]; mx = fmaxf(mx, sv[kt][r]); }
                } else {
#pragma unroll
                    for (int kt = 0; kt < 2; ++kt)
#pragma unroll
                        for (int r = 0; r < 4; ++r) {
                            const int kk = kk0 + 16 * kt + 4 * fq + r, d = kk - 128 - qi, prel = Q0rel + kk - 128;
                            const bool valid = d >= -128 && d <= 128 && prel >= 0 && prel < L && kk < 384;
                            sv[kt][r] = valid ? st[kt][r] : -1e30f;
                            mx = fmaxf(mx, sv[kt][r]);
                        }
                }
                mx = fmaxf(mx, shx(mx, 16, lane)); mx = fmaxf(mx, shx(mx, 32, lane));
                const float mn = fmaxf(mrun, mx), alpha = __builtin_amdgcn_exp2f(mrun - mn);
                mrun = mn;
                float pr[2][4], psum = 0.f;
#pragma unroll
                for (int kt = 0; kt < 2; ++kt)
#pragma unroll
                    for (int r = 0; r < 4; ++r) { pr[kt][r] = __builtin_amdgcn_exp2f(sv[kt][r] - mn); psum += pr[kt][r]; }
                lsum = lsum * alpha + psum;
                union { bf16x8 v; unsigned u[4]; } pf;
                pf.u[0] = pk2(pr[0][0], pr[0][1]); pf.u[1] = pk2(pr[0][2], pr[0][3]); pf.u[2] = pk2(pr[1][0], pr[1][1]); pf.u[3] = pk2(pr[1][2], pr[1][3]);
#pragma unroll
                for (int dt = 0; dt < 4; ++dt) {
                    o[dt] = o[dt] * alpha;
                    union { bf16x8 v; u32x2 h[2]; } vf;
                    vf.h[0] = *(const u32x2*)(Vt + (16 * dt + fr) * 404 + kk0 + 4 * fq);
                    vf.h[1] = *(const u32x2*)(Vt + (16 * dt + fr) * 404 + kk0 + 16 + 4 * fq);
                    o[dt] = __builtin_amdgcn_mfma_f32_16x16x32_bf16(vf.v, pf.v, o[dt], 0, 0, 0);
                }
            }
            lsum += shx(lsum, 16, lane); lsum += shx(lsum, 32, lane);
            const float il = frcp(lsum);
            bf16_t* dst = p->Y + (size_t)(Q0 + qi) * DM + h * 64 + 4 * fq;
#pragma unroll
            for (int dt = 0; dt < 4; ++dt) { u32x2 w; w.x = pk2(o[dt].x * il, o[dt].y * il); w.y = pk2(o[dt].z * il, o[dt].w * il); *(u32x2*)(dst + 16 * dt) = w; }
        }
    }
}

__device__ __forceinline__ void ph_hyena_pre(KP p, int l, unsigned char* sm, int wv) {
    constexpr int ZS = 513;
    unsigned* zt = (unsigned*)sm;
    bf16_t* vt = (bf16_t*)(sm + 34 * ZS * 4);
    float* cw = (float*)(sm + 34 * ZS * 4 + 512 * 80);
    const bf16_t* Z = p->ZA;
    const int tid = otid(wv), tt = tid & 31, cg = tid >> 5;
    const float* ws = p->w_short + (size_t)l * 3 * 1536; const float* bs = p->b_short + l * 1536;
    __syncthreads();
    cw[tid] = ws[512 + tid]; cw[512 + tid] = ws[1536 + 512 + tid]; cw[1024 + tid] = ws[3072 + 512 + tid]; cw[1536 + tid] = bs[512 + tid];
    cw[2048 + tid] = ws[1024 + tid]; cw[2560 + tid] = ws[1536 + 1024 + tid]; cw[3072 + tid] = ws[3072 + 1024 + tid]; cw[3584 + tid] = bs[1024 + tid];
    u32x4 pre[9];
    {
        const int t0 = obid() * 32; int sbase, L; seq_of(t0, sbase, L);
#pragma unroll
        for (int i = 0; i < 9; ++i) {
            const int q = tid + 512 * i, r = q >> 7, ch = q & 127, t = t0 - 1 + r;
            pre[i] = (u32x4){0u, 0u, 0u, 0u};
            if (q < 34 * 128 && t >= sbase && t < sbase + L) pre[i] = *(const u32x4*)(Z + (size_t)t * DIN + 1280 + ch * 8);
        }
    }
    for (int tile = obid(); tile < 1536; tile += ogrid()) {
        const int t0 = tile * 32;
        __syncthreads();
#pragma unroll
        for (int i = 0; i < 9; ++i) {
            const int q = tid + 512 * i, r = q >> 7, ch = q & 127;
            if (q < 34 * 128) { unsigned* d = zt + r * ZS + ch * 4; d[0] = pre[i].x; d[1] = pre[i].y; d[2] = pre[i].z; d[3] = pre[i].w; }
        }
        __syncthreads();
        {
            const int tn = tile + ogrid();
            if (tn < 1536) {
                const int t0n = tn * 32; int sbn, Ln; seq_of(t0n, sbn, Ln);
#pragma unroll
                for (int i = 0; i < 9; ++i) {
                    const int q = tid + 512 * i, r = q >> 7, ch = q & 127, t = t0n - 1 + r;
                    pre[i] = (u32x4){0u, 0u, 0u, 0u};
                    if (q < 34 * 128 && t >= sbn && t < sbn + Ln) pre[i] = *(const u32x4*)(Z + (size_t)t * DIN + 1280 + ch * 8);
                }
            }
        }
#pragma unroll 4
        for (int i = 0; i < 16; ++i) {
            const int c = cg * 32 + 2 * i;
            const unsigned a_p = zt[tt * ZS + (c >> 1)], a_c = zt[(tt + 1) * ZS + (c >> 1)], a_n = zt[(tt + 2) * ZS + (c >> 1)];
            const unsigned g_p = zt[tt * ZS + 256 + (c >> 1)], g_c = zt[(tt + 1) * ZS + 256 + (c >> 1)], g_n = zt[(tt + 2) * ZS + 256 + (c >> 1)];
            const float u1a = cw[c] * bflo(a_p) + cw[512 + c] * bflo(a_c) + cw[1024 + c] * bflo(a_n) + cw[1536 + c];
            const float u2a = cw[2048 + c] * bflo(g_p) + cw[2560 + c] * bflo(g_c) + cw[3072 + c] * bflo(g_n) + cw[3584 + c];
            const float u1b = cw[c + 1] * bfhi(a_p) + cw[513 + c] * bfhi(a_c) + cw[1025 + c] * bfhi(a_n) + cw[1537 + c];
            const float u2b = cw[2049 + c] * bfhi(g_p) + cw[2561 + c] * bfhi(g_c) + cw[3073 + c] * bfhi(g_n) + cw[3585 + c];
            const unsigned pk = pk2(u1a * u2a, u1b * u2b);
            vt[c * 40 + tt] = (bf16_t)(pk & 0xffffu); vt[(c + 1) * 40 + tt] = (bf16_t)(pk >> 16);
        }
        __syncthreads();
#pragma unroll
        for (int i = 0; i < 4; ++i) {
            const int q = tid + 512 * i, cc = q >> 2, part = q & 3;
            *(u32x4*)(p->V + (size_t)cc * T + t0 + part * 8) = *(const u32x4*)(vt + cc * 40 + part * 8);
        }
    }
}

__device__ __forceinline__ void ph_filtergen(KP p, int l, unsigned char* sm, int wv) {
    float* zf = (float*)sm;
    float* h1 = zf + 64 * 34;
    float* h2 = h1 + 64 * 65;
    float* w1s = h2 + 64 * 68;
    float* w2s = w1s + 33 * 64;
    float* ot = w2s + 64 * 64;
    const int tid = otid(wv), wid = tid >> 6, lane = tid & 63;
    const float* b1 = p->fb1 + l * 64; const float* f1 = p->ffr1 + l * 64;
    const float* b2 = p->fb2 + l * 64; const float* f2 = p->ffr2 + l * 64;
    const float* w3 = p->fw3 + (size_t)l * 65536; const float* hb = p->hbias + l * 512;
    __syncthreads();
    for (int i = tid; i < 33 * 64; i += 512) w1s[i] = p->fw1[l * 33 * 64 + i];
    for (int i = tid; i < 64 * 64; i += 512) w2s[i] = p->fw2[l * 4096 + i];
    for (int item = obid(); item < 384; item += ogrid()) {
        const int L = item < 256 ? LP : LSQ, n0 = (item < 256 ? item : item - 256) * 64;
        bf16_t* kf = p->X + (item < 256 ? 0 : 16777216);
        __syncthreads();
        {
            const int n = n0 + lane;
            const float w = 2.0f * (float)n / (float)L;
#pragma unroll
            for (int q = 0; q < 2; ++q) {
                const int b = wid * 2 + q;
                const float f = 1e-4f + (float)b * 0.9999933333333334f;
                const float ht = f * w, red = ht - 2.0f * rintf(0.5f * ht);
                const float2 cs = twid_precise(0.5f * red);
                zf[lane * 34 + 1 + b] = cs.x; zf[lane * 34 + 17 + b] = -cs.y;
            }
            if (wid == 0) zf[lane * 34] = (float)n / (float)(L - 1);
        }
        __syncthreads();
        {
            float a[8];
#pragma unroll
            for (int i = 0; i < 8; ++i) a[i] = b1[wid * 8 + i];
#pragma unroll 3
            for (int f = 0; f < 33; ++f) {
                const float zv = zf[lane * 34 + f];
                const f32x4 w0 = *(const f32x4*)(w1s + f * 64 + wid * 8), w1v = *(const f32x4*)(w1s + f * 64 + wid * 8 + 4);
                a[0] += zv * w0.x; a[1] += zv * w0.y; a[2] += zv * w0.z; a[3] += zv * w0.w; a[4] += zv * w1v.x; a[5] += zv * w1v.y; a[6] += zv * w1v.z; a[7] += zv * w1v.w;
            }
#pragma unroll
            for (int i = 0; i < 8; ++i) h1[lane * 65 + wid * 8 + i] = sinpif(f1[wid * 8 + i] * a[i] * 0.3183098861837907f);
        }
        __syncthreads();
        {
            float a[8];
#pragma unroll
            for (int i = 0; i < 8; ++i) a[i] = b2[wid * 8 + i];
#pragma unroll 4
            for (int j = 0; j < 64; ++j) {
                const float zv = h1[lane * 65 + j];
                const f32x4 w0 = *(const f32x4*)(w2s + j * 64 + wid * 8), w1v = *(const f32x4*)(w2s + j * 64 + wid * 8 + 4);
                a[0] += zv * w0.x; a[1] += zv * w0.y; a[2] += zv * w0.z; a[3] += zv * w0.w; a[4] += zv * w1v.x; a[5] += zv * w1v.y; a[6] += zv * w1v.z; a[7] += zv * w1v.w;
            }
#pragma unroll
            for (int i = 0; i < 8; ++i) h2[lane * 68 + wid * 8 + i] = sinpif(f2[wid * 8 + i] * a[i] * 0.3183098861837907f);
        }
        __syncthreads();
#pragma unroll 1
        for (int pass = 0; pass < 4; ++pass) {
            const int ol = tid & 255, o = pass * 256 + ol, ph0 = (tid >> 8) * 32;
            float wcol[64];
#pragma unroll
            for (int j = 0; j < 64; ++j) wcol[j] = w3[j * 1024 + o];
#pragma unroll 2
            for (int pp = 0; pp < 32; ++pp) {
                const f32x4* hr = (const f32x4*)(h2 + (ph0 + pp) * 68);
                float acc0 = 0.f, acc1 = 0.f;
#pragma unroll
                for (int j4 = 0; j4 < 16; ++j4) { const f32x4 hv = hr[j4]; acc0 += hv.x * wcol[j4 * 4] + hv.z * wcol[j4 * 4 + 2]; acc1 += hv.y * wcol[j4 * 4 + 1] + hv.w * wcol[j4 * 4 + 3]; }
                ot[ol * 65 + ph0 + pp] = acc0 + acc1;
            }
            __syncthreads();
            for (int e = tid; e < 256 * 64; e += 512) {
                const int ol2 = e >> 6, pos = e & 63, o2 = pass * 256 + ol2, c = o2 & 511, n = n0 + pos;
                const float tt = (float)n / (float)(L - 1);
                const float delta = fabsf(-3.070113457325394f + (float)c * ((-15.350567286626971f + 3.070113457325394f) / 511.0f));
                float val = ot[ol2 * 65 + pos] * __expf(-tt * delta);
                bf16_t* kc = kf + (size_t)c * (2 * L);
                if (o2 < 512) { if (n == 0) val += hb[c]; kc[n] = (bf16_t)(pk2(val, 0.f) & 0xffffu); }
                else { if (n >= 1) kc[2 * L - n] = (bf16_t)(pk2(val, 0.f) & 0xffffu); else kc[L] = (bf16_t)0; }
            }
            __syncthreads();
        }
    }
}

__device__ __forceinline__ float2 cmul(float2 a, float2 b) { return make_float2(a.x * b.x - a.y * b.y, a.x * b.y + a.y * b.x); }
__device__ __forceinline__ float2 cadd(float2 a, float2 b) { return make_float2(a.x + b.x, a.y + b.y); }
__device__ __forceinline__ float2 csub(float2 a, float2 b) { return make_float2(a.x - b.x, a.y - b.y); }

__device__ __forceinline__ int PD(int i) { return i + (i >> 4); }
template <bool TW>
__device__ __forceinline__ void fft16_fwd(float2 (&x)[16], float2 T1) {
    const float C[8] = {1.0f, 0.92387953251128674f, 0.70710678118654752f, 0.38268343236508977f, 0.0f, -0.38268343236508977f, -0.70710678118654752f, -0.92387953251128674f};
    const float S[8] = {0.0f, 0.38268343236508977f, 0.70710678118654752f, 0.92387953251128674f, 1.0f, 0.92387953251128674f, 0.70710678118654752f, 0.38268343236508977f};
    float2 Ts = T1;
#pragma unroll
    for (int st = 0; st < 4; ++st) {
        const int half = 8 >> st;
#pragma unroll
        for (int i = 0; i < 8; ++i) {
            const int g = i / half, j = i % half, pp = g * 2 * half + j, ti = j * (8 / half);
            const float2 a = x[pp], b = x[pp + half], d = csub(a, b);
            x[pp] = cadd(a, b);
            const float2 dw = cmul(d, make_float2(C[ti], -S[ti]));
            x[pp + half] = TW ? cmul(dw, Ts) : dw;
        }
        if (TW) Ts = cmul(Ts, Ts);
    }
}
template <bool TW>
__device__ __forceinline__ void fft16_inv(float2 (&x)[16], float2 T1c) {
    const float C[8] = {1.0f, 0.92387953251128674f, 0.70710678118654752f, 0.38268343236508977f, 0.0f, -0.38268343236508977f, -0.70710678118654752f, -0.92387953251128674f};
    const float S[8] = {0.0f, 0.38268343236508977f, 0.70710678118654752f, 0.92387953251128674f, 1.0f, 0.92387953251128674f, 0.70710678118654752f, 0.38268343236508977f};
    const float2 T2 = cmul(T1c, T1c), T4 = cmul(T2, T2), T8 = cmul(T4, T4);
#pragma unroll
    for (int st = 0; st < 4; ++st) {
        const int half = 1 << st;
        const float2 Ts = st == 0 ? T8 : (st == 1 ? T4 : (st == 2 ? T2 : T1c));
#pragma unroll
        for (int i = 0; i < 8; ++i) {
            const int g = i / half, j = i % half, pp = g * 2 * half + j, ti = j * (8 / half);
            const float2 bw = cmul(x[pp + half], make_float2(C[ti], S[ti]));
            const float2 a = x[pp], b = TW ? cmul(bw, Ts) : bw;
            x[pp] = cadd(a, b); x[pp + half] = csub(a, b);
        }
    }
}
template <bool FWD>
__device__ __forceinline__ void fft_pass16(float2* z, int Lc, int ls, int tid) {
    const int s = 1 << ls, os = ls >= 4 ? s + (s >> 4) : 1;
    const float its = 0.0625f / (float)s;
    for (int q = tid; q < (Lc >> 4); q += 512) {
        const int g = q >> ls, j = q & (s - 1), pb = PD((g << (ls + 4)) + j);
        float2 x[16];
#pragma unroll
        for (int k = 0; k < 16; ++k) x[k] = z[pb + k * os];
        if (ls == 0) { if (FWD) fft16_fwd<false>(x, make_float2(1.f, 0.f)); else fft16_inv<false>(x, make_float2(1.f, 0.f)); }
        else { const float2 T1 = twid((FWD ? -1.0f : 1.0f) * (float)j * its); if (FWD) fft16_fwd<true>(x, T1); else fft16_inv<true>(x, T1); }
#pragma unroll
        for (int k = 0; k < 16; ++k) z[pb + k * os] = x[k];
    }
    __syncthreads();
}
__device__ __forceinline__ void fft_fwd(float2* z, int lg, int tid) {
    const int Lc = 1 << lg; const int lh = lg - 1;
    if (lg & 1) {
        const int h = 1 << lh, oh = h + (h >> 4);
        for (int j = tid; j < h; j += 512) {
            const int pj = PD(j);
            const float2 a = z[pj], b = z[pj + oh];
            z[pj] = cadd(a, b); z[pj + oh] = cmul(csub(a, b), twid(-(float)j * (0.5f / (float)h)));
        }
        __syncthreads();
    } else {
        const int h = 1 << lh, hh = h >> 1, oh = h + (h >> 4), ohh = hh + (hh >> 4);
        const float ih2 = 0.5f / (float)h;
        for (int q0 = tid; q0 < (Lc >> 2); q0 += 2048) {
            float2 x[4][4]; int pbs[4]; float2 w1s[4];
#pragma unroll
            for (int u = 0; u < 4; ++u) {
                const int q = q0 + 512 * u, g = q >> (lh - 1), j = q & (hh - 1), pb = PD((g << (lh + 1)) + j);
                pbs[u] = pb; w1s[u] = twid(-(float)j * ih2);
                x[u][0] = z[pb]; x[u][1] = z[pb + ohh]; x[u][2] = z[pb + oh]; x[u][3] = z[pb + oh + ohh];
            }
#pragma unroll
            for (int u = 0; u < 4; ++u) {
                const float2 w1 = w1s[u], w2 = cmul(w1, w1);
                const float2 a0 = cadd(x[u][0], x[u][2]), a2 = cmul(csub(x[u][0], x[u][2]), w1), a1 = cadd(x[u][1], x[u][3]), t3 = cmul(csub(x[u][1], x[u][3]), w1);
                const float2 a3 = make_float2(t3.y, -t3.x);
                x[u][0] = cadd(a0, a1); x[u][1] = cmul(csub(a0, a1), w2); x[u][2] = cadd(a2, a3); x[u][3] = cmul(csub(a2, a3), w2);
            }
#pragma unroll
            for (int u = 0; u < 4; ++u) { const int pb = pbs[u]; z[pb] = x[u][0]; z[pb + ohh] = x[u][1]; z[pb + oh] = x[u][2]; z[pb + oh + ohh] = x[u][3]; }
        }
        __syncthreads();
    }
    fft_pass16<true>(z, Lc, 8, tid);
    fft_pass16<true>(z, Lc, 4, tid);
    fft_pass16<true>(z, Lc, 0, tid);
}
__device__ __forceinline__ void fft_inv(float2* z, int lg, int tid) {
    const int Lc = 1 << lg; const int lh = 12;
    fft_pass16<false>(z, Lc, 0, tid);
    fft_pass16<false>(z, Lc, 4, tid);
    fft_pass16<false>(z, Lc, 8, tid);
    if (lg & 1) {
        const int h = 1 << lh, oh = h + (h >> 4);
        for (int j = tid; j < h; j += 512) {
            const int pj = PD(j);
            const float2 a = z[pj], b = cmul(z[pj + oh], twid((float)j * (0.5f / (float)h)));
            z[pj] = cadd(a, b); z[pj + oh] = csub(a, b);
        }
        __syncthreads();
    } else {
        const int h = 1 << lh, oh = h + (h >> 4);
        const float ih4 = 0.25f / (float)h;
        for (int q0 = tid; q0 < (Lc >> 2); q0 += 2048) {
            float2 x[4][4]; int pbs[4]; float2 cws[4];
#pragma unroll
            for (int u = 0; u < 4; ++u) {
                const int q = q0 + 512 * u, g = q >> lh, j = q & (h - 1), pb = PD((g << (lh + 2)) + j);
                pbs[u] = pb; cws[u] = twid((float)j * ih4);
                x[u][0] = z[pb]; x[u][1] = z[pb + oh]; x[u][2] = z[pb + 2 * oh]; x[u][3] = z[pb + 3 * oh];
            }
#pragma unroll
            for (int u = 0; u < 4; ++u) {
                const float2 cwb = cws[u], cwa = cmul(cwb, cwb);
                const float2 t1 = cmul(x[u][1], cwa), a0 = cadd(x[u][0], t1), a1 = csub(x[u][0], t1), t3 = cmul(x[u][3], cwa), a2 = cadd(x[u][2], t3), a3 = csub(x[u][2], t3);
                const float2 u2 = cmul(a2, cwb), u3t = cmul(a3, cwb), u3 = make_float2(-u3t.y, u3t.x);
                x[u][0] = cadd(a0, u2); x[u][2] = csub(a0, u2); x[u][1] = cadd(a1, u3); x[u][3] = csub(a1, u3);
            }
#pragma unroll
            for (int u = 0; u < 4; ++u) { const int pb = pbs[u]; z[pb] = x[u][0]; z[pb + oh] = x[u][1]; z[pb + 2 * oh] = x[u][2]; z[pb + 3 * oh] = x[u][3]; }
        }
        __syncthreads();
    }
}

__device__ __forceinline__ void ph_filter_fft(KP p, unsigned char* sm, int wv) {
    float2* z = (float2*)sm;
    const int tid = otid(wv);
    for (int item = obid(); item < 1024; item += ogrid()) {
        const int big = item < 512, c = item & 511, lg = big ? 14 : 13, Lc = 1 << lg;
        unsigned* g = (unsigned*)p->X + (big ? 0 : 8388608) + (size_t)c * Lc;
        __syncthreads();
#pragma unroll 4
        for (int i = tid; i < (Lc >> 2); i += 512) {
            const u32x4 v = *(const u32x4*)(g + 4 * i); const int pi = PD(4 * i);
            z[pi] = make_float2(bflo(v.x), bfhi(v.x)); z[pi + 1] = make_float2(bflo(v.y), bfhi(v.y)); z[pi + 2] = make_float2(bflo(v.z), bfhi(v.z)); z[pi + 3] = make_float2(bflo(v.w), bfhi(v.w));
        }
        __syncthreads();
        fft_fwd(z, lg, tid);
        const float sc = 1.0f / (float)Lc;
        for (int k = tid; k <= (Lc >> 1); k += 512) {
            if (k == 0) { const float2 Z0 = z[0]; g[0] = pk2((Z0.x + Z0.y) * sc, (Z0.x - Z0.y) * sc); continue; }
            const int pk = (int)(__brev((unsigned)k) >> (32 - lg)), pm = (int)(__brev((unsigned)(Lc - k)) >> (32 - lg));
            const float2 Zk = z[PD(pk)], Zm = z[PD(pm)];
            const float2 E = make_float2(0.5f * (Zk.x + Zm.x), 0.5f * (Zk.y - Zm.y));
            const float2 O = make_float2(0.5f * (Zk.y + Zm.y), -0.5f * (Zk.x - Zm.x));
            const float2 wO = cmul(twid(-(float)k * (0.5f / (float)Lc)), O);
            const float2 Xk = cadd(E, wO), Xm0 = csub(E, wO);
            g[k] = pk2(Xk.x * sc, Xk.y * sc);
            g[Lc - k] = pk2(Xm0.x * sc, -Xm0.y * sc);
        }
    }
}

template <int LG>
__device__ __forceinline__ void pair_one(float2* z, int k, float2 Kk, float2 Km) {
    constexpr int Lc = 1 << LG;
    const int pk = (int)(__brev((unsigned)k) >> (32 - LG)), pm = (int)(__brev((unsigned)(Lc - k)) >> (32 - LG));
    const float2 Zk = z[PD(pk)], Zm = z[PD(pm)];
    const float2 E = make_float2(0.5f * (Zk.x + Zm.x), 0.5f * (Zk.y - Zm.y));
    const float2 O = make_float2(0.5f * (Zk.y + Zm.y), -0.5f * (Zk.x - Zm.x));
    const float2 w = twid(-(float)k * (0.5f / (float)Lc));
    const float2 wO = cmul(w, O);
    const float2 Xk = cadd(E, wO), Xm0 = csub(E, wO), Xm = make_float2(Xm0.x, -Xm0.y);
    const float2 Yk = cmul(Xk, Kk), Ym = cmul(Xm, Km);
    const float2 E2 = make_float2(0.5f * (Yk.x + Ym.x), 0.5f * (Yk.y - Ym.y));
    const float2 D2 = make_float2(0.5f * (Yk.x - Ym.x), 0.5f * (Yk.y + Ym.y));
    const float2 O2 = cmul(D2, make_float2(w.x, -w.y));
    z[PD(pk)] = make_float2(E2.x - O2.y, E2.y + O2.x);
    if (pm != pk) z[PD(pm)] = make_float2(E2.x + O2.y, -E2.y + O2.x);
}
template <int LG, int NSEQ>
__device__ __forceinline__ void fftconv_channel(float2* z, const unsigned* spec, bf16_t* v0, int tid0) {
    constexpr int Lc = 1 << LG, NK = Lc / 1024, NL = Lc / 4096;
    unsigned sku[NK], smu[NK];
#pragma unroll
    for (int i = 0; i < NK; ++i) { const int k = tid0 + 512 * i; sku[i] = spec[k]; smu[i] = spec[(Lc - k) & (Lc - 1)]; }
    const unsigned shu = spec[Lc >> 1];
#pragma unroll 1
    for (int sq = 0; sq < NSEQ; ++sq) {
        int tid = tid0; asm volatile("" : "+v"(tid));
        bf16_t* v = v0 + (size_t)sq * Lc;
        u32x4 raw[NL];
#pragma unroll
        for (int i = 0; i < NL; ++i) raw[i] = *(const u32x4*)(v + 8 * (tid + 512 * i));
        __syncthreads();
#pragma unroll
        for (int i = 0; i < NL; ++i) {
            const int pi = PD(4 * (tid + 512 * i));
            z[pi] = make_float2(bflo(raw[i].x), bfhi(raw[i].x)); z[pi + 1] = make_float2(bflo(raw[i].y), bfhi(raw[i].y));
            z[pi + 2] = make_float2(bflo(raw[i].z), bfhi(raw[i].z)); z[pi + 3] = make_float2(bflo(raw[i].w), bfhi(raw[i].w));
        }
        for (int i = (Lc >> 1) + tid; i < Lc; i += 512) z[PD(i)] = make_float2(0.f, 0.f);
        int lgv = LG; asm volatile("" : "+s"(lgv));
        __syncthreads();
        fft_fwd(z, lgv, tid);
#pragma unroll
        for (int i = 0; i < NK; ++i) {
            int tz = 0; asm volatile("" : "+v"(tz));
            const int k = tid + tz + 512 * i;
            if (k == 0) { const float2 Z0 = z[0], K0 = make_float2(bflo(sku[0]), bfhi(sku[0])); const float Y0 = (Z0.x + Z0.y) * K0.x, YL = (Z0.x - Z0.y) * K0.y; z[0] = make_float2(0.5f * (Y0 + YL), 0.5f * (Y0 - YL)); }
            else pair_one<LG>(z, k, make_float2(bflo(sku[i]), bfhi(sku[i])), make_float2(bflo(smu[i]), bfhi(smu[i])));
        }
        if (tid == 0) pair_one<LG>(z, Lc >> 1, make_float2(bflo(shu), bfhi(shu)), make_float2(bflo(shu), bfhi(shu)));
        __syncthreads();
        fft_inv(z, lgv, tid);
#pragma unroll
        for (int i = 0; i < NL; ++i) {
            const int pi = PD(4 * (tid + 512 * i)); const float2 a = z[pi], b = z[pi + 1], cc = z[pi + 2], d = z[pi + 3];
            u32x4 o; o.x = pk2(a.x, a.y); o.y = pk2(b.x, b.y); o.z = pk2(cc.x, cc.y); o.w = pk2(d.x, d.y);
            *(u32x4*)(v + 8 * (tid + 512 * i)) = o;
        }
    }
}
__device__ __forceinline__ void ph_fftconv(KP p, unsigned char* sm, int wv) {
    float2* z = (float2*)sm;
    const int tid0 = otid(wv);
    for (int c = obid(); c < 512; c += ogrid()) {
        int tid = tid0; asm volatile("" : "+v"(tid));
        fftconv_channel<14, 1>(z, (const unsigned*)p->X + (size_t)c * 16384, p->V + (size_t)c * T, tid);
        asm volatile("" : "+v"(tid));
        fftconv_channel<13, 4>(z, (const unsigned*)p->X + 8388608 + (size_t)c * 8192, p->V + (size_t)c * T + LP, tid);
    }
}

__device__ __forceinline__ void ph_mixfinal(KP p, int l, unsigned char* sm, int wv) {
    constexpr int ZS = 257;
    bf16_t* yt = (bf16_t*)sm;
    unsigned* zt = (unsigned*)(sm + 73728);
    float* part = (float*)(sm + 73728 + 66 * ZS * 4);
    float* cw = part + 512;
    const bf16_t* Z = p->ZA;
    const int tid = otid(wv), wid = tid >> 6, lane = tid & 63, tt = lane, cg = wid;
    const float* ws = p->w_short + (size_t)l * 3 * 1536; const float* bs = p->b_short + l * 1536;
    const float* gh = p->nho + l * 512;
    __syncthreads();
    cw[tid] = ws[tid]; cw[512 + tid] = ws[1536 + tid]; cw[1024 + tid] = ws[3072 + tid]; cw[1536 + tid] = bs[tid];
    for (int tile = obid(); tile < 768; tile += ogrid()) {
        const int t0 = tile * 64; int sbase, L; seq_of(t0, sbase, L);
        const int tend = sbase + L;
        u32x4 arow[8];
#pragma unroll
        for (int i = 0; i < 8; ++i) arow[i] = *(const u32x4*)(p->Y + (size_t)(t0 + wid * 8 + i) * DM + lane * 8);
        __syncthreads();
#pragma unroll
        for (int i = 0; i < 8; ++i) {
            const int q = tid + 512 * i, cc = q >> 3, pt = q & 7;
            *(u32x4*)(yt + cc * 72 + pt * 8) = *(const u32x4*)(p->V + (size_t)cc * T + t0 + pt * 8);
        }
        for (int q = tid; q < 66 * 64; q += 512) {
            const int r = q >> 6, ch = q & 63, t = t0 - 1 + r;
            u32x4 v = (u32x4){0u, 0u, 0u, 0u};
            if (t >= sbase && t < tend) v = *(const u32x4*)(Z + (size_t)t * DIN + 768 + ch * 8);
            unsigned* d = zt + r * ZS + ch * 4;
            d[0] = v.x; d[1] = v.y; d[2] = v.z; d[3] = v.w;
        }
        __syncthreads();
        unsigned hyp[32]; float sq = 0.f;
#pragma unroll
        for (int i = 0; i < 32; ++i) {
            const int c = cg * 64 + 2 * i;
            const unsigned z_p = zt[tt * ZS + (c >> 1)], z_c = zt[(tt + 1) * ZS + (c >> 1)], z_n = zt[(tt + 2) * ZS + (c >> 1)];
            const float x0a = cw[c] * bflo(z_p) + cw[512 + c] * bflo(z_c) + cw[1024 + c] * bflo(z_n) + cw[1536 + c];
            const float x0b = cw[c + 1] * bfhi(z_p) + cw[513 + c] * bfhi(z_c) + cw[1025 + c] * bfhi(z_n) + cw[1537 + c];
            const float ha = x0a * bf1(yt[c * 72 + tt]), hb = x0b * bf1(yt[(c + 1) * 72 + tt]);
            sq += ha * ha + hb * hb;
            hyp[i] = pk2(ha, hb);
        }
        part[tt * 8 + cg] = sq;
        __syncthreads();
        {
            const f32x4 q0 = *(const f32x4*)(part + tt * 8), q1 = *(const f32x4*)(part + tt * 8 + 4);
            const float sm_ = ((q0.x + q0.y) + (q0.z + q0.w)) + ((q1.x + q1.y) + (q1.z + q1.w));
            const float r = rsqrtf(sm_ * (1.0f / 512.0f) + EPS);
            bf16_t* dst = p->Y + (size_t)(t0 + tt) * DM + 512 + cg * 64;
#pragma unroll
            for (int i8 = 0; i8 < 8; ++i8) {
                const f32x4 g0 = *(const f32x4*)(gh + cg * 64 + i8 * 8), g1 = *(const f32x4*)(gh + cg * 64 + i8 * 8 + 4);
                u32x4 o;
                o.x = pk2(bflo(hyp[i8 * 4]) * r * g0.x, bfhi(hyp[i8 * 4]) * r * g0.y); o.y = pk2(bflo(hyp[i8 * 4 + 1]) * r * g0.z, bfhi(hyp[i8 * 4 + 1]) * r * g0.w);
                o.z = pk2(bflo(hyp[i8 * 4 + 2]) * r * g1.x, bfhi(hyp[i8 * 4 + 2]) * r * g1.y); o.w = pk2(bflo(hyp[i8 * 4 + 3]) * r * g1.z, bfhi(hyp[i8 * 4 + 3]) * r * g1.w);
                *(u32x4*)(dst + i8 * 8) = o;
            }
        }
        const f32x4 ga0 = *(const f32x4*)(p->nao + l * 512 + lane * 8), ga1 = *(const f32x4*)(p->nao + l * 512 + lane * 8 + 4);
#pragma unroll
        for (int i = 0; i < 8; ++i) {
            const int t = t0 + wid * 8 + i;
            bf16_t* rowp = p->Y + (size_t)t * DM + lane * 8;
            const u32x4 raw = arow[i];
            float x[8] = {bflo(raw.x), bfhi(raw.x), bflo(raw.y), bfhi(raw.y), bflo(raw.z), bfhi(raw.z), bflo(raw.w), bfhi(raw.w)};
            float s = 0.f;
#pragma unroll
            for (int k = 0; k < 8; ++k) s += x[k] * x[k];
            s = wave_sum(s, lane);
            const float r = rsqrtf(s * (1.0f / 512.0f) + EPS);
            u32x4 o; o.x = pk2(x[0] * r * ga0.x, x[1] * r * ga0.y); o.y = pk2(x[2] * r * ga0.z, x[3] * r * ga0.w); o.z = pk2(x[4] * r * ga1.x, x[5] * r * ga1.y); o.w = pk2(x[6] * r * ga1.z, x[7] * r * ga1.w);
            *(u32x4*)rowp = o;
        }
    }
}

enum { OP_XCONV = 0, OP_WCONV, OP_GEMM_IN, OP_FILTERGEN, OP_ATTN, OP_HPRE, OP_FFFT, OP_FFTCONV, OP_MIXFINAL, OP_GEMM_OUT, OP_PCONV, OP_GEMM_UP, OP_GEMM_DOWN, OP_GEMM_GATE, OP_GEMM_PROJ };
__global__ void __launch_bounds__(512, 2) mega(P p_arg) {
    extern __shared__ __attribute__((aligned(16))) unsigned char smem[];
    LAS unsigned char* lds = (LAS unsigned char*)smem;
    const int nseq = p_arg.nseq;
    const int wv = __builtin_amdgcn_readfirstlane((int)(threadIdx.x >> 6));
    for (int si = 0; si < nseq; ++si) {
        KP p = (KP)__builtin_amdgcn_kernarg_segment_ptr();
        asm volatile("" : "+s"(p));
        const int code = __builtin_amdgcn_readfirstlane(p->seq[si]), op = code & 31, l = (code >> 5) & 3;
        const bf16_t* Wl = p->W + (size_t)(l & 1) * W_LAYER;
        if (op == OP_XCONV) ph_xconv(p, wv);
        else if (op == OP_WCONV) ph_wconv(p, l, smem, wv);
        else if (op == OP_GEMM_IN) { Sched S; S.init(192, 9, 0); EpiIn E{p->ZA, p->ss_in}; gemm_phase(lds, l == 0 ? (const bf16_t*)p->Y : (const bf16_t*)p->out, Wl + WO_IN, 1024, S, E, wv); }
        else if (op == OP_FILTERGEN) ph_filtergen(p, l, smem, wv);
        else if (op == OP_ATTN) ph_attn(p, l, smem, wv);
        else if (op == OP_HPRE) ph_hyena_pre(p, l, smem, wv);
        else if (op == OP_FFFT) ph_filter_fft(p, smem, wv);
        else if (op == OP_FFTCONV) ph_fftconv(p, smem, wv);
        else if (op == OP_MIXFINAL) ph_mixfinal(p, l, smem, wv);
        else if (op == OP_GEMM_OUT) { Sched S; S.init(192, 4, 0); EpiRes E{p->xp, p->xs, (const bf16_t*)p->out, p->X, p->ss_ffn, l == 0 ? 0 : 1}; gemm_phase(lds, p->Y, Wl + WO_OUT, 1024, S, E, wv); }
        else if (op == OP_PCONV) ph_pconv(p, l, wv);
        else if (op == OP_GEMM_UP) { Sched S; S.init(197, 22, 1); EpiUp E{p->ZA, p->ss_ffn, p->w_ffconv + (size_t)l * 3 * 5632, p->b_ffconv + (size_t)l * 5632}; gemm_phase(lds, p->X, Wl + WO_UP, 1024, S, E, wv); }
        else if (op == OP_GEMM_DOWN) { Sched S; S.init(192, 4, 0); EpiRes E{p->xp, p->xs, p->X, p->X, nullptr, 1}; gemm_phase(lds, p->ZA, Wl + WO_DOWN, 2816, S, E, wv); }
        else if (op == OP_GEMM_GATE) { Sched S; S.init(192, 4, 0); EpiGate E{p->ZA}; gemm_phase(lds, p->X, Wl + WO_GATE, 1024, S, E, wv); }
        else { Sched S; S.init(192, 4, 0); EpiProj E{p->ZA, p->X, p->out, (bf16_t*)p->out, p->ss_in, l == NLAYER - 1 ? 1 : 0}; gemm_phase(lds, p->V, Wl + WO_PROJ, 256, S, E, wv); }
        if (code & 128) { if (si + 1 < nseq) cg::this_grid().sync(); }
        else __syncthreads();
    }
}

extern "C" void kernel_launch(void* const* d_in, const int* in_sizes, int n_in, void* d_out, int out_size, void* d_ws, size_t ws_size, hipStream_t stream) {
    static int grid = 0;
    if (grid == 0) {
        if (n_in != 29 || out_size != T * DM || ws_size < WS_END) { fprintf(stderr, "kernel_launch: unexpected shapes (n_in %d out %d ws %zu need %zu)\n", n_in, out_size, ws_size, (size_t)WS_END); grid = -1; return; }
        int dev = 0, cus = 0, per_cu = 0;
        hipGetDevice(&dev);
        hipDeviceGetAttribute(&cus, hipDeviceAttributeMultiprocessorCount, dev);
        if (hipFuncSetAttribute((const void*)mega, hipFuncAttributeMaxDynamicSharedMemorySize, LDS_BYTES) != hipSuccess) { fprintf(stderr, "kernel_launch: hipFuncSetAttribute failed\n"); grid = -1; return; }
        if (hipOccupancyMaxActiveBlocksPerMultiprocessor(&per_cu, (const void*)mega, 512, LDS_BYTES) != hipSuccess || per_cu < 1) per_cu = 1;
        (void)hipGetLastError();
        grid = cus * per_cu;
    }
    if (grid < 0) return;
    P p{};
    const float** f = (const float**)&p;
    for (int i = 0; i < 29; ++i) f[i] = (const float*)d_in[i];
    p.out = (float*)d_out;
    unsigned char* ws = (unsigned char*)d_ws;
    p.X = (bf16_t*)(ws + OFF_X); p.Y = (bf16_t*)(ws + OFF_Y); p.ZA = (bf16_t*)(ws + OFF_ZA); p.V = (bf16_t*)(ws + OFF_V); p.W = (bf16_t*)(ws + OFF_W);
    p.ss_in = (float*)(ws + OFF_SSI); p.ss_ffn = (float*)(ws + OFF_SSF);
    int ns = 0;
#define EMIT(op, l, sync) p.seq[ns++] = ((op) | ((l) << 5) | ((sync) ? 128 : 0))
    EMIT(OP_XCONV, 0, 0); EMIT(OP_WCONV, 0, 1);
    for (int l = 0; l < NLAYER; ++l) {
        EMIT(OP_GEMM_IN, l, 0); EMIT(OP_FILTERGEN, l, 1);
        EMIT(OP_ATTN, l, 0); EMIT(OP_HPRE, l, 0);
        if (l + 1 < NLAYER) { EMIT(OP_FFFT, l, 0); EMIT(OP_WCONV, l + 1, 1); } else EMIT(OP_FFFT, l, 1);
#if PROBE_MASK & 1
        EMIT(OP_ATTN, l, 1);
#endif
#if PROBE_MASK & 2
        EMIT(OP_HPRE, l, 1);
#endif
#if PROBE_MASK & 4
        EMIT(OP_FILTERGEN, l, 1); EMIT(OP_FFFT, l, 1);
#endif
#if PROBE_MASK & 8
        if (l + 1 < NLAYER) EMIT(OP_WCONV, l + 1, 1);
#endif
        EMIT(OP_FFTCONV, l, 1);
#if PROBE_MASK & 16
        EMIT(OP_HPRE, l, 1); EMIT(OP_FFTCONV, l, 1);
#endif
        EMIT(OP_MIXFINAL, l, 1);
#if PROBE_MASK & 32
        EMIT(OP_ATTN, l, 1); EMIT(OP_MIXFINAL, l, 1);
#endif
        EMIT(OP_GEMM_OUT, l, 0); EMIT(OP_PCONV, l, 1);
#if PROBE_MASK & 128
        for (int r = 0; r < 4; ++r) EMIT(OP_PCONV, l, 1);
#endif
        EMIT(OP_GEMM_UP, l, 1);
#if PROBE_MASK & 64
        EMIT(OP_GEMM_UP, l, 1);
#endif
        EMIT(OP_GEMM_DOWN, l, 1);
        EMIT(OP_GEMM_GATE, l, 0);
        EMIT(OP_GEMM_PROJ, l, 1);
    }
#undef EMIT
    p.nseq = ns;
    void* args[] = {&p};
    hipError_t e = hipLaunchCooperativeKernel((const void*)mega, dim3(grid), dim3(512), args, LDS_BYTES, stream);
    if (e != hipSuccess) fprintf(stderr, "cooperative launch failed: %s (grid %d)\n", hipGetErrorString(e), grid);
}
```

```cpp
#include <hip/hip_runtime.h>
#include <hip/hip_cooperative_groups.h>
#include <cstdio>
#include <cstdint>
namespace cg = cooperative_groups;

#ifndef PROBE_MASK
#define PROBE_MASK 0
#endif

#define LAS __attribute__((address_space(3)))
typedef unsigned short bf16_t;
typedef short bf16x8 __attribute__((ext_vector_type(8)));
typedef float f32x4 __attribute__((ext_vector_type(4)));
typedef unsigned u32x4 __attribute__((ext_vector_type(4)));
typedef unsigned u32x2 __attribute__((ext_vector_type(2)));

constexpr int T = 49152, LP = 16384, LSQ = 8192, DM = 1024, DIN = 2304, DFF = 2816, NLAYER = 4;
constexpr float EPS = 1e-6f;
constexpr int LDS_BYTES = 159744;
constexpr int NPHASE = 1 + 9 * NLAYER;

constexpr size_t GUARD = 256 * 2048;
constexpr size_t SZ_HB = (size_t)T * DM * 2;
constexpr size_t OFF_X = GUARD;
constexpr size_t OFF_Y = OFF_X + SZ_HB + GUARD;
constexpr size_t OFF_ZA = OFF_Y + SZ_HB + GUARD;
constexpr size_t SZ_ZA = (size_t)T * DFF * 2;
constexpr size_t OFF_V = OFF_ZA + SZ_ZA;
constexpr size_t SZ_V = (size_t)T * 512 * 2;
constexpr size_t OFF_W = OFF_V + SZ_V;
constexpr size_t W_LAYER = 13369344;
constexpr size_t SZ_W = 2 * W_LAYER * 2;
constexpr size_t OFF_SSI = OFF_W + SZ_W;
constexpr size_t SZ_SS = (size_t)T * 16 * 4;
constexpr size_t OFF_SSF = OFF_SSI + SZ_SS;
constexpr size_t WS_END = OFF_SSF + SZ_SS;
constexpr size_t WO_IN = 0, WO_OUT = 2359296, WO_UP = 3407872, WO_DOWN = 9175040, WO_GATE = 12058624, WO_PROJ = 13107200;

struct P {
    const float *xp, *xs, *pp, *ps;
    const float *rms_mix, *w_in, *q_norm, *k_norm, *sink, *w_short, *b_short, *fw1, *fb1, *ffr1, *fw2, *fb2, *ffr2, *fw3, *hbias, *nao, *nho, *w_out, *rms_ffn, *w_up, *w_ffconv, *b_ffconv, *w_down, *w_gate, *w_proj;
    float* out;
    bf16_t *X, *Y, *ZA, *V, *W;
    float *ss_in, *ss_ffn;
    int nseq; int seq[125];
};

typedef const __attribute__((address_space(4))) P* KP;

__device__ __forceinline__ unsigned pk2(float lo, float hi) { unsigned r; asm volatile("v_cvt_pk_bf16_f32 %0, %1, %2" : "=v"(r) : "v"(lo), "v"(hi)); return r; }
__device__ __forceinline__ float bflo(unsigned u) { return __uint_as_float(u << 16); }
__device__ __forceinline__ float bfhi(unsigned u) { return __uint_as_float(u & 0xffff0000u); }
__device__ __forceinline__ float2 twid(float turns) { return make_float2(__builtin_amdgcn_cosf(turns), __builtin_amdgcn_sinf(turns)); }
__device__ __forceinline__ float2 twid_precise(float turns) { float s_, c_; sincospif(2.0f * turns, &s_, &c_); return make_float2(c_, s_); }
__device__ __forceinline__ float frcp(float x) { return 1.0f / x; }
__device__ __forceinline__ float rcp_nr(float x) { const float y = __builtin_amdgcn_rcpf(x); return __builtin_fmaf(y, __builtin_fmaf(-x, y, 1.0f), y); }
__device__ __forceinline__ float bf1(bf16_t h) { return __uint_as_float(((unsigned)h) << 16); }
__device__ __forceinline__ int otid(int wv) { unsigned z = 0; asm volatile("" : "+v"(z)); int t = wv * 64 + (int)__builtin_amdgcn_mbcnt_hi(~0u, __builtin_amdgcn_mbcnt_lo(~0u, z)); asm volatile("" : "+v"(t)); return t; }
__device__ __forceinline__ int obid() { int b = blockIdx.x; asm volatile("" : "+s"(b)); return b; }
__device__ __forceinline__ int ogrid() { int g = gridDim.x; asm volatile("" : "+s"(g)); return g; }
__device__ __forceinline__ float shx(float v, int mask, int lane) { return __int_as_float(__builtin_amdgcn_ds_bpermute((lane ^ mask) << 2, __float_as_int(v))); }
__device__ __forceinline__ float wave_sum(float v, int lane) {
#pragma unroll
    for (int o = 32; o >= 1; o >>= 1) v += shx(v, o, lane);
    return v;
}
__device__ __forceinline__ void seq_of(int t, int& sbase, int& L) {
    if (t < LP) { sbase = 0; L = LP; } else { sbase = LP + ((t - LP) / LSQ) * LSQ; L = LSQ; }
}

__device__ __forceinline__ void ph_xconv(KP p, int wv) {
    const int tid0 = otid(wv), wid = tid0 >> 6, lane = tid0 & 63;
    for (int t = obid() * 8 + wid; t < T; t += ogrid() * 8) {
        const float* src = t < LP ? p->xp + (size_t)t * DM : p->xs + (size_t)(t - LP) * DM;
        float ss = 0.f;
#pragma unroll
        for (int i = 0; i < 4; ++i) {
            f32x4 v = *(const f32x4*)(src + i * 256 + lane * 4);
            ss += v.x * v.x + v.y * v.y + v.z * v.z + v.w * v.w;
            u32x2 o; o.x = pk2(v.x, v.y); o.y = pk2(v.z, v.w);
            *(u32x2*)(p->Y + (size_t)t * DM + i * 256 + lane * 4) = o;
        }
        ss = wave_sum(ss, lane);
        if (lane < 16) p->ss_in[(size_t)t * 16 + lane] = lane == 0 ? ss : 0.f;
    }
}

__device__ __forceinline__ void ph_wconv(KP p, int l, unsigned char* sm, int wv) {
    float* tl = (float*)sm;
    bf16_t* Wl = p->W + (size_t)(l & 1) * W_LAYER;
    const int tid = otid(wv);
    for (int g = obid(); g < 3264; g += ogrid()) {
        const float* src; const float* gain = nullptr; bf16_t* dst; int K, N, tile;
        if (g < 576) { src = p->w_in + (size_t)l * 1024 * 2304; gain = p->rms_mix + l * 1024; dst = Wl + WO_IN; K = 1024; N = 2304; tile = g; }
        else if (g < 832) { src = p->w_out + (size_t)l * 1024 * 1024; dst = Wl + WO_OUT; K = 1024; N = 1024; tile = g - 576; }
        else if (g < 2240) { src = p->w_up + (size_t)l * 1024 * 5632; gain = p->rms_ffn + l * 1024; dst = Wl + WO_UP; K = 1024; N = 5632; tile = g - 832; }
        else if (g < 2944) { src = p->w_down + (size_t)l * 2816 * 1024; dst = Wl + WO_DOWN; K = 2816; N = 1024; tile = g - 2240; }
        else if (g < 3200) { src = p->w_gate + (size_t)l * 1024 * 1024; dst = Wl + WO_GATE; K = 1024; N = 1024; tile = g - 2944; }
        else { src = p->w_proj + (size_t)l * 256 * 1024; dst = Wl + WO_PROJ; K = 256; N = 1024; tile = g - 3200; }
        const int ntn = N / 64, k0 = (tile / ntn) * 64, n0 = (tile % ntn) * 64;
        __syncthreads();
#pragma unroll
        for (int i = 0; i < 8; ++i) {
            const int r = (tid >> 6) + 8 * i, c = tid & 63;
            float v = src[(size_t)(k0 + r) * N + n0 + c];
            if (gain) v *= gain[k0 + r];
            tl[r * 65 + c] = v;
        }
        __syncthreads();
#pragma unroll
        for (int i = 0; i < 8; ++i) {
            const int r = (tid >> 6) + 8 * i, c = tid & 63;
            unsigned pk = pk2(tl[c * 65 + r], 0.f);
            dst[(size_t)(n0 + r) * K + k0 + c] = (bf16_t)(pk & 0xffffu);
        }
    }
}

__device__ __forceinline__ void ph_pconv(KP p, int l, int wv) {
    for (int i = obid() * 512 + otid(wv); i < T * 32; i += ogrid() * 512) {
        const int t = i >> 5, c8 = (i & 31) * 8;
        const float* src = t < LP ? p->pp + ((size_t)l * LP + t) * 256 + c8 : p->ps + ((size_t)l * 32768 + (t - LP)) * 256 + c8;
        f32x4 a = *(const f32x4*)src, b = *(const f32x4*)(src + 4);
        u32x4 o; o.x = pk2(a.x, a.y); o.y = pk2(a.z, a.w); o.z = pk2(b.x, b.y); o.w = pk2(b.z, b.w);
        *(u32x4*)(p->V + (size_t)t * 256 + c8) = o;
    }
}

constexpr int BM = 256, BK = 64, HALF = 128, HTB = HALF * BK * 2, NXCD = 8, WGM = 4;
__device__ __forceinline__ int lds_byte(int r, int c) { const int st = (r >> 4) * 2 + (c >> 5), rr = r & 15, cc = c & 31, ob = rr * 64 + cc * 2; return st * 1024 + (ob ^ (((ob >> 9) & 1) << 5)); }
__device__ __forceinline__ void stage_rc(int b, int& R, int& C) { const int st = b / 1024, sb = b % 1024, swz = sb ^ (((sb >> 9) & 1) << 5); R = (st >> 1) * 16 + swz / 64; C = (st & 1) * 32 + (swz % 64) / 2; }
__device__ __forceinline__ int perm32(int rho) { const int n = rho >> 4, i = rho & 15; return 8 * (i >> 2) + 4 * n + (i & 3); }

struct Unit { int pm, pn; long arow; int b0, b1; };
struct Sched {
    int nM, nN, nwg, G, c, mode;
    __device__ __forceinline__ void init(int nM_, int nN_, int mode_) { nM = nM_; nN = nN_; nwg = nM * nN; G = ogrid(); c = obid(); mode = mode_; }
    __device__ __forceinline__ bool next(int i, Unit& u) const {
        const long Lx = (long)i * G + c; if (Lx >= nwg) return false;
        int wgid = (int)Lx; { const int q = nwg / NXCD, r = nwg % NXCD, xcd = wgid % NXCD, off = wgid / NXCD; wgid = (xcd < r ? xcd * (q + 1) : r * (q + 1) + (xcd - r) * q) + off; }
        const int nig = WGM * nN, gid = wgid / nig, fm = gid * WGM, gsz = (nM - fm) < WGM ? (nM - fm) : WGM;
        u.pm = fm + ((wgid % nig) % gsz); u.pn = (wgid % nig) / gsz;
        if (mode == 0) { u.arow = (long)u.pm * 256; u.b0 = u.pn * 256; u.b1 = u.pn * 256 + 128; }
        else {
            int sb, i2; if (u.pm < 65) { sb = 0; i2 = u.pm; } else { const int r = u.pm - 65; sb = LP + (r / 33) * LSQ; i2 = r % 33; }
            u.arow = (long)sb + 254 * i2 - 1; u.b0 = u.pn * 128; u.b1 = DFF + u.pn * 128;
        }
        return true;
    }
};

template <class Epi>
__device__ __forceinline__ void gemm_phase(LAS unsigned char* lds, const bf16_t* Ag, const bf16_t* Btg, const int K, const Sched& S, const Epi& E, int wv) {
    const int tid = otid(wv), wid = __builtin_amdgcn_readfirstlane(tid >> 6), lane = tid & 63, wr = wid >> 2, wc = wid & 3, fr = lane & 15, fq = lane >> 4;
    const int nt = K / BK;
    unsigned voffA[2], voffB[2];
#pragma unroll
    for (int i = 0; i < 2; ++i) { int R, C; stage_rc(tid * 16 + i * 8192, R, C); const int Rb = (R & ~31) + perm32(R & 31);
        voffA[i] = (unsigned)(R * K + C) * 2u; voffB[i] = (unsigned)(Rb * K + C) * 2u; }
    const size_t kstep = (size_t)(BK * 2);
    const size_t hstep = (size_t)HALF * K * 2;
    const size_t rowb = (size_t)K * 2;
    const unsigned ldsw = (unsigned)wid * 1024u;
    const int aoff = lds_byte(wr * 64 + fr, fq * 8), boff = lds_byte(wc * 32 + fr, fq * 8);
#define G_SA(b, h) (((b) * 2 + (h)) * HTB)
#define G_SB(b, h) ((4 + (b) * 2 + (h)) * HTB)
#define G_STAGE(bufoff, gbase, voff) do { const char* _gb = (const char*)(gbase); asm volatile("" : "+s"(_gb)); _Pragma("unroll") for (int _i = 0; _i < 2; ++_i) \
        __builtin_amdgcn_global_load_lds((const unsigned*)(_gb + (voff)[_i]), (LAS unsigned*)(lds + (bufoff) + ldsw + _i * 8192), 16, 0, 0); } while (0)
#define G_LDA(dst, b, h) do { _Pragma("unroll") for (int m = 0; m < 4; ++m) _Pragma("unroll") for (int k = 0; k < 2; ++k) dst[m][k] = *(const LAS bf16x8*)(lds + G_SA(b, h) + aoff + m * 2048 + k * 1024); } while (0)
#define G_LDB(dst, b, h) do { _Pragma("unroll") for (int n = 0; n < 2; ++n) _Pragma("unroll") for (int k = 0; k < 2; ++k) dst[n][k] = *(const LAS bf16x8*)(lds + G_SB(b, h) + boff + n * 2048 + k * 1024); } while (0)
#define G_MMA(ai, bj, At, Bt) do { __builtin_amdgcn_s_setprio(1); _Pragma("unroll") for (int m = 0; m < 4; ++m) _Pragma("unroll") for (int n = 0; n < 2; ++n) _Pragma("unroll") for (int k = 0; k < 2; ++k) \
        acc[ai][bj][m][n] = __builtin_amdgcn_mfma_f32_16x16x32_bf16(Bt[n][k], At[m][k], acc[ai][bj][m][n], 0, 0, 0); __builtin_amdgcn_s_setprio(0); } while (0)
#define G_WAIT_V(n) asm volatile("s_waitcnt vmcnt(" #n ")" ::: "memory")
#define G_WAIT_L(n) asm volatile("s_waitcnt lgkmcnt(" #n ")" ::: "memory")
#define G_BAR __builtin_amdgcn_s_barrier()
#define G_SCHED __builtin_amdgcn_sched_barrier(0)
    Unit cur, nxt; int ui = 0;
    if (!S.next(0, cur)) return;
    f32x4 acc[2][2][4][2];
#pragma unroll
    for (int a = 0; a < 2; ++a)
#pragma unroll
        for (int b = 0; b < 2; ++b)
#pragma unroll
            for (int m = 0; m < 4; ++m)
#pragma unroll
                for (int n = 0; n < 2; ++n) acc[a][b][m][n] = (f32x4){0.f, 0.f, 0.f, 0.f};
    bf16x8 At[4][2], B0[2][2], B1[2][2];
    const char* cA = (const char*)Ag + cur.arow * (long)rowb;
    const char* cB0 = (const char*)Btg + (size_t)cur.b0 * rowb;
    const char* cB1 = (const char*)Btg + (size_t)cur.b1 * rowb;
    G_STAGE(G_SB(0, 0), cB0, voffB); G_STAGE(G_SA(0, 0), cA, voffA); G_STAGE(G_SB(0, 1), cB1, voffB); G_STAGE(G_SA(0, 1), cA + hstep, voffA);
    if (wr == 1) G_BAR;
    G_WAIT_V(4); G_BAR;
    G_STAGE(G_SB(1, 0), cB0 + kstep, voffB); G_STAGE(G_SA(1, 0), cA + kstep, voffA); G_STAGE(G_SB(1, 1), cB1 + kstep, voffB);
    G_WAIT_V(6); G_BAR;
    for (;;) {
        const bool has_next = S.next(ui + 1, nxt);
        const char* nA = has_next ? (const char*)Ag + nxt.arow * (long)rowb : cA;
        const char* nB0 = has_next ? (const char*)Btg + (size_t)nxt.b0 * rowb : cB0;
        const char* nB1 = has_next ? (const char*)Btg + (size_t)nxt.b1 * rowb : cB1;
        for (int t = 0; t < nt; t += 2) {
            const bool last = (t == nt - 2);
            const char* a1 = cA + (size_t)(t + 1) * kstep;
            const char* a2 = last ? nA : cA + (size_t)(t + 2) * kstep;
            const char* b20 = last ? nB0 : cB0 + (size_t)(t + 2) * kstep;
            const char* b21 = last ? nB1 : cB1 + (size_t)(t + 2) * kstep;
            const char* a3 = a2 + kstep; const char* b30 = b20 + kstep; const char* b31 = b21 + kstep;
            G_LDB(B0, 0, 0); G_SCHED; G_LDA(At, 0, 0); G_STAGE(G_SA(1, 1), a1 + hstep, voffA);
            G_WAIT_L(8); G_BAR; G_WAIT_L(0); G_MMA(0, 0, At, B0); G_BAR; G_SCHED;
            G_LDB(B1, 0, 1); G_STAGE(G_SB(0, 0), b20, voffB);
            G_BAR; G_WAIT_L(0); G_MMA(0, 1, At, B1); G_BAR;
            G_LDA(At, 0, 1); G_STAGE(G_SA(0, 0), a2, voffA);
            G_BAR; G_WAIT_L(0); G_MMA(1, 0, At, B0); G_BAR; G_SCHED;
            G_STAGE(G_SB(0, 1), b21, voffB);
            G_WAIT_V(6); G_BAR; G_MMA(1, 1, At, B1); G_BAR;
            G_LDB(B0, 1, 0); G_SCHED; G_LDA(At, 1, 0); G_STAGE(G_SA(0, 1), a2 + hstep, voffA);
            G_WAIT_L(8); G_BAR; G_WAIT_L(0); G_MMA(0, 0, At, B0); G_BAR; G_SCHED;
            G_LDB(B1, 1, 1); G_STAGE(G_SB(1, 0), b30, voffB);
            G_BAR; G_WAIT_L(0); G_MMA(0, 1, At, B1); G_BAR;
            G_LDA(At, 1, 1); G_STAGE(G_SA(1, 0), a3, voffA);
            G_BAR; G_WAIT_L(0); G_MMA(1, 0, At, B0); G_BAR; G_SCHED;
            G_STAGE(G_SB(1, 1), b31, voffB);
            G_WAIT_V(6); G_BAR; G_MMA(1, 1, At, B1); G_BAR;
        }
        E(acc, cur, wr, wc, fr, fq, lds);
        if (!has_next) break;
#pragma unroll
        for (int a = 0; a < 2; ++a)
#pragma unroll
            for (int b = 0; b < 2; ++b)
#pragma unroll
                for (int m = 0; m < 4; ++m)
#pragma unroll
                    for (int n = 0; n < 2; ++n) acc[a][b][m][n] = (f32x4){0.f, 0.f, 0.f, 0.f};
        cur = nxt; cA = nA; cB0 = nB0; cB1 = nB1; ++ui;
    }
    G_WAIT_V(0);
    if (wr == 0) G_BAR;
    G_BAR;
#undef G_SA
#undef G_SB
#undef G_STAGE
#undef G_LDA
#undef G_LDB
#undef G_MMA
}

constexpr int EPI_XB = 131072, EPI_RS = 131072 + 4096, EPI_CW = 131072 + 5120;
__device__ __forceinline__ void stage_rstd(LAS unsigned char* lds, const float* ss, int tid, long grow0, int sr0, int L) {
    if (tid < 256) {
        const int sr = sr0 + tid; const bool valid = sr >= 0 && sr < L;
        const f32x4* q = (const f32x4*)(ss + (size_t)(valid ? grow0 + tid : 0) * 16);
        const f32x4 a = q[0], b = q[1], c = q[2], d = q[3];
        const float sm_ = ((a.x + a.y) + (a.z + a.w)) + ((b.x + b.y) + (b.z + b.w)) + ((c.x + c.y) + (c.z + c.w)) + ((d.x + d.y) + (d.z + d.w));
        ((LAS float*)(lds + EPI_RS))[tid] = valid ? rsqrtf(sm_ * (1.0f / 1024.0f) + EPS) : 0.f;
    }
}
#define EPI_SYNC() do { asm volatile("s_waitcnt lgkmcnt(0)" ::: "memory"); __builtin_amdgcn_s_barrier(); __builtin_amdgcn_s_barrier(); asm volatile("" ::: "memory"); } while (0)

struct EpiIn {
    bf16_t* Z; const float* ss;
    __device__ __forceinline__ void operator()(f32x4 (&acc)[2][2][4][2], const Unit& u, int wr, int wc, int fr, int fq, LAS unsigned char* lds) const {
        asm volatile("" : "+v"(fr), "+v"(fq), "+s"(wr), "+s"(wc));
        const int tid = (wr * 4 + wc) * 64 + fq * 16 + fr;
        stage_rstd(lds, ss, tid, (long)u.pm * 256, 0, 1 << 30);
        EPI_SYNC();
        const LAS float* rs = (const LAS float*)(lds + EPI_RS);
        const int row0 = u.pm * 256 + wr * 64 + fr, col0 = wc * 32 + 8 * fq;
#pragma unroll
        for (int ai = 0; ai < 2; ++ai)
#pragma unroll
            for (int m = 0; m < 4; ++m) {
                const int row = row0 + ai * 128 + m * 16; const float r = rs[128 * ai + 64 * wr + 16 * m + fr];
#pragma unroll
                for (int bj = 0; bj < 2; ++bj) {
                    const f32x4 v0 = acc[ai][bj][m][0] * r, v1 = acc[ai][bj][m][1] * r;
                    u32x4 o; o.x = pk2(v0.x, v0.y); o.y = pk2(v0.z, v0.w); o.z = pk2(v1.x, v1.y); o.w = pk2(v1.z, v1.w);
                    *(u32x4*)(Z + (size_t)row * DIN + (bj ? u.b1 : u.b0) + col0) = o;
                }
            }
    }
};
struct EpiRes {
    const float* xp; const float* xs; const bf16_t* rsrc; bf16_t* hb; float* ss; int mode;
    __device__ __forceinline__ void operator()(f32x4 (&acc)[2][2][4][2], const Unit& u, int wr, int wc, int fr, int fq, LAS unsigned char*) const {
        asm volatile("" : "+v"(fr), "+v"(fq), "+s"(wr), "+s"(wc));
        const int row0 = u.pm * 256 + wr * 64 + fr, col0 = wc * 32 + 8 * fq;
#pragma unroll
        for (int ai = 0; ai < 2; ++ai) {
            __builtin_amdgcn_sched_barrier(0);
            f32x4 rv[4][2][2];
            if (mode == 0) {
#pragma unroll
                for (int m = 0; m < 4; ++m) {
                    const int row = row0 + ai * 128 + m * 16;
                    const float* rp = row < LP ? xp + (size_t)row * DM : xs + (size_t)(row - LP) * DM;
#pragma unroll
                    for (int bj = 0; bj < 2; ++bj) { const int col = (bj ? u.b1 : u.b0) + col0; rv[m][bj][0] = *(const f32x4*)(rp + col); rv[m][bj][1] = *(const f32x4*)(rp + col + 4); }
                }
            } else {
                u32x4 rb[4][2];
#pragma unroll
                for (int m = 0; m < 4; ++m)
#pragma unroll
                    for (int bj = 0; bj < 2; ++bj) rb[m][bj] = *(const u32x4*)(rsrc + (size_t)(row0 + ai * 128 + m * 16) * DM + (bj ? u.b1 : u.b0) + col0);
#pragma unroll
                for (int m = 0; m < 4; ++m)
#pragma unroll
                    for (int bj = 0; bj < 2; ++bj) {
                        const u32x4 q = rb[m][bj];
                        rv[m][bj][0] = (f32x4){bflo(q.x), bfhi(q.x), bflo(q.y), bfhi(q.y)}; rv[m][bj][1] = (f32x4){bflo(q.z), bfhi(q.z), bflo(q.w), bfhi(q.w)};
                    }
            }
            __builtin_amdgcn_sched_barrier(0);
#pragma unroll
            for (int m = 0; m < 4; ++m) {
                const int row = row0 + ai * 128 + m * 16;
                float sq = 0.f;
#pragma unroll
                for (int bj = 0; bj < 2; ++bj) {
                    const int col = (bj ? u.b1 : u.b0) + col0;
                    const f32x4 h0 = rv[m][bj][0] + acc[ai][bj][m][0], h1 = rv[m][bj][1] + acc[ai][bj][m][1];
                    sq += h0.x * h0.x + h0.y * h0.y + h0.z * h0.z + h0.w * h0.w + h1.x * h1.x + h1.y * h1.y + h1.z * h1.z + h1.w * h1.w;
                    u32x4 o; o.x = pk2(h0.x, h0.y); o.y = pk2(h0.z, h0.w); o.z = pk2(h1.x, h1.y); o.w = pk2(h1.z, h1.w);
                    *(u32x4*)(hb + (size_t)row * DM + col) = o;
                }
                if (ss) { sq += shx(sq, 16, fq * 16 + fr); sq += shx(sq, 32, fq * 16 + fr); if (fq == 0) ss[(size_t)row * 16 + u.pn * 4 + wc] = sq; }
            }
        }
    }
};
struct EpiGate {
    bf16_t* Sg;
    __device__ __forceinline__ void operator()(f32x4 (&acc)[2][2][4][2], const Unit& u, int wr, int wc, int fr, int fq, LAS unsigned char*) const {
        asm volatile("" : "+v"(fr), "+v"(fq), "+s"(wr), "+s"(wc));
        const int row0 = u.pm * 256 + wr * 64 + fr, col0 = wc * 32 + 8 * fq;
#pragma unroll
        for (int ai = 0; ai < 2; ++ai)
#pragma unroll
            for (int m = 0; m < 4; ++m) {
                __builtin_amdgcn_sched_barrier(0); const int row = row0 + ai * 128 + m * 16;
#pragma unroll
                for (int bj = 0; bj < 2; ++bj) {
                    float s[8];
#pragma unroll
                    for (int n = 0; n < 2; ++n)
#pragma unroll
                        for (int j = 0; j < 4; ++j) s[n * 4 + j] = rcp_nr(1.0f + fminf(__expf(-acc[ai][bj][m][n][j]), 1e30f));
                    u32x4 o; o.x = pk2(s[0], s[1]); o.y = pk2(s[2], s[3]); o.z = pk2(s[4], s[5]); o.w = pk2(s[6], s[7]);
                    *(u32x4*)(Sg + (size_t)row * DM + (bj ? u.b1 : u.b0) + col0) = o;
                }
            }
    }
};
struct EpiProj {
    const bf16_t* Sg; const bf16_t* hbx; float* out; bf16_t* hb; float* ss; int last;
    __device__ __forceinline__ void operator()(f32x4 (&acc)[2][2][4][2], const Unit& u, int wr, int wc, int fr, int fq, LAS unsigned char*) const {
        asm volatile("" : "+v"(fr), "+v"(fq), "+s"(wr), "+s"(wc));
        const int row0 = u.pm * 256 + wr * 64 + fr, col0 = wc * 32 + 8 * fq;
#pragma unroll
        for (int ai = 0; ai < 2; ++ai)
#pragma unroll
            for (int mp = 0; mp < 2; ++mp) {
                __builtin_amdgcn_sched_barrier(0);
                u32x4 sgv[2][2], ovb[2][2]; f32x4 ov[2][2][2];
#pragma unroll
                for (int mm = 0; mm < 2; ++mm) {
                    const int row = row0 + ai * 128 + (mp * 2 + mm) * 16;
#pragma unroll
                    for (int bj = 0; bj < 2; ++bj) {
                        const int col = (bj ? u.b1 : u.b0) + col0;
                        sgv[mm][bj] = *(const u32x4*)(Sg + (size_t)row * DM + col);
                        ovb[mm][bj] = *(const u32x4*)(hbx + (size_t)row * DM + col);
                    }
                }
                __builtin_amdgcn_sched_barrier(0);
#pragma unroll
                for (int mm = 0; mm < 2; ++mm)
#pragma unroll
                    for (int bj = 0; bj < 2; ++bj) {
                        const u32x4 q = ovb[mm][bj];
                        ov[mm][bj][0] = (f32x4){bflo(q.x), bfhi(q.x), bflo(q.y), bfhi(q.y)}; ov[mm][bj][1] = (f32x4){bflo(q.z), bfhi(q.z), bflo(q.w), bfhi(q.w)};
                    }
#pragma unroll
                for (int mm = 0; mm < 2; ++mm) {
                    const int m = mp * 2 + mm, row = row0 + ai * 128 + m * 16;
                    float sq = 0.f;
#pragma unroll
                    for (int bj = 0; bj < 2; ++bj) {
                        const int col = (bj ? u.b1 : u.b0) + col0;
                        const u32x4 sg = sgv[mm][bj];
                        f32x4 g0, g1; g0.x = bflo(sg.x); g0.y = bfhi(sg.x); g0.z = bflo(sg.y); g0.w = bfhi(sg.y); g1.x = bflo(sg.z); g1.y = bfhi(sg.z); g1.z = bflo(sg.w); g1.w = bfhi(sg.w);
                        const f32x4 h0 = ov[mm][bj][0] + g0 * acc[ai][bj][m][0], h1 = ov[mm][bj][1] + g1 * acc[ai][bj][m][1];
                        if (last) { float* op = out + (size_t)row * DM + col; *(f32x4*)op = h0; *(f32x4*)(op + 4) = h1; }
                        sq += h0.x * h0.x + h0.y * h0.y + h0.z * h0.z + h0.w * h0.w + h1.x * h1.x + h1.y * h1.y + h1.z * h1.z + h1.w * h1.w;
                        if (!last) { u32x4 o; o.x = pk2(h0.x, h0.y); o.y = pk2(h0.z, h0.w); o.z = pk2(h1.x, h1.y); o.w = pk2(h1.z, h1.w); *(u32x4*)(hb + (size_t)row * DM + col) = o; }
                    }
                    sq += shx(sq, 16, fq * 16 + fr); sq += shx(sq, 32, fq * 16 + fr); if (fq == 0 && !last) ss[(size_t)row * 16 + u.pn * 4 + wc] = sq;
                }
            }
    }
};
__device__ __forceinline__ unsigned dppu_ror1(unsigned x) { return (unsigned)__builtin_amdgcn_update_dpp(0, (int)x, 0x121, 0xf, 0xf, false); }
__device__ __forceinline__ unsigned dppu_ror15(unsigned x) { return (unsigned)__builtin_amdgcn_update_dpp(0, (int)x, 0x12F, 0xf, 0xf, false); }
struct EpiUp {
    bf16_t* act; const float* ss; const float* w3; const float* b3;
    __device__ __forceinline__ void operator()(f32x4 (&acc)[2][2][4][2], const Unit& u, int wr, int wc, int fr, int fq, LAS unsigned char* lds) const {
        asm volatile("" : "+v"(fr), "+v"(fq), "+s"(wr), "+s"(wc));
        int sb, L, i2; if (u.pm < 65) { sb = 0; L = LP; i2 = u.pm; } else { const int r = u.pm - 65; sb = LP + (r / 33) * LSQ; L = LSQ; i2 = r % 33; }
        const int sr0 = 254 * i2 - 1;
        const int tid = (wr * 4 + wc) * 64 + fq * 16 + fr;
        stage_rstd(lds, ss, tid, (long)sb + sr0, sr0, L);
        {
            LAS float* cw = (LAS float*)(lds + EPI_CW);
#pragma unroll
            for (int i = 0; i < 2; ++i) {
                const int e = tid + 512 * i, bj = e >> 9, k = (e >> 7) & 3, c = e & 127;
                cw[e] = k < 3 ? w3[k * 2 * DFF + bj * DFF + u.b0 + c] : b3[bj * DFF + u.b0 + c];
            }
        }
        EPI_SYNC();
        const LAS float* rs = (const LAS float*)(lds + EPI_RS);
        unsigned pq[2][2][4][2][2];
#pragma unroll
        for (int ai = 0; ai < 2; ++ai)
#pragma unroll
            for (int m = 0; m < 4; ++m) {
                const float r = rs[128 * ai + 64 * wr + 16 * m + fr];
#pragma unroll
                for (int bj = 0; bj < 2; ++bj)
#pragma unroll
                    for (int n = 0; n < 2; ++n) {
                        const f32x4 v = acc[ai][bj][m][n];
                        pq[ai][bj][m][n][0] = r != 0.f ? pk2(v.x * r, v.y * r) : 0u;
                        pq[ai][bj][m][n][1] = r != 0.f ? pk2(v.z * r, v.w * r) : 0u;
                    }
            }
        LAS unsigned* xb = (LAS unsigned*)(lds + EPI_XB);
        const int clp = 16 * wc + 4 * fq;
        if (fr == 0) {
#pragma unroll
            for (int ai = 0; ai < 2; ++ai)
#pragma unroll
                for (int bj = 0; bj < 2; ++bj)
#pragma unroll
                    for (int n = 0; n < 2; ++n) { u32x2 t; t.x = pq[ai][bj][0][n][0]; t.y = pq[ai][bj][0][n][1]; *(LAS u32x2*)(xb + ((ai * 2 + wr) * 2 + 0) * 128 + 64 * bj + clp + 2 * n) = t; }
        }
        if (fr == 15) {
#pragma unroll
            for (int ai = 0; ai < 2; ++ai)
#pragma unroll
                for (int bj = 0; bj < 2; ++bj)
#pragma unroll
                    for (int n = 0; n < 2; ++n) { u32x2 t; t.x = pq[ai][bj][3][n][0]; t.y = pq[ai][bj][3][n][1]; *(LAS u32x2*)(xb + ((ai * 2 + wr) * 2 + 1) * 128 + 64 * bj + clp + 2 * n) = t; }
        }
        EPI_SYNC();
        constexpr bool r1prev = true;
        const int cl = 32 * wc + 8 * fq;
#pragma unroll
        for (int ai = 0; ai < 2; ++ai) {
            const int pa = wr ? ai : ai - 1, pw = wr ? 0 : 1, na = wr ? ai + 1 : ai, nw = wr ? 0 : 1;
            const bool hasp = pa >= 0 && fr == 0, hasn = na < 2 && fr == 15;
            unsigned outp[4][4];
#pragma unroll
            for (int n = 0; n < 2; ++n) {
                const LAS unsigned* xp_ = xb + (((pa < 0 ? 0 : pa) * 2 + pw) * 2 + 1) * 128 + clp + 2 * n;
                const LAS unsigned* xn_ = xb + (((na > 1 ? 1 : na) * 2 + nw) * 2 + 0) * 128 + clp + 2 * n;
#pragma unroll
                for (int jp = 0; jp < 2; ++jp) {
                    __builtin_amdgcn_sched_barrier(0);
                    float ag[2][4][2];
#pragma unroll
                    for (int bj = 0; bj < 2; ++bj) {
                        const LAS float* cwp = (const LAS float*)(lds + EPI_CW) + bj * 512 + cl + 4 * n + 2 * jp;
                        const float w0a = cwp[0], w0b = cwp[1], w1a = cwp[128], w1b = cwp[129], w2a = cwp[256], w2b = cwp[257], bba = cwp[384], bbb = cwp[385];
                        const unsigned hpv = hasp ? xp_[64 * bj + jp] : 0u, hnv = hasn ? xn_[64 * bj + jp] : 0u;
                        unsigned cv[4], ra[4], rb[4];
#pragma unroll
                        for (int m = 0; m < 4; ++m) { cv[m] = pq[ai][bj][m][n][jp]; const unsigned x1 = dppu_ror1(cv[m]), x15 = dppu_ror15(cv[m]); ra[m] = r1prev ? x1 : x15; rb[m] = r1prev ? x15 : x1; }
#pragma unroll
                        for (int m = 0; m < 4; ++m) {
                            const unsigned pv = fr > 0 ? ra[m] : (m > 0 ? ra[m > 0 ? m - 1 : 0] : hpv);
                            const unsigned nv = fr < 15 ? rb[m] : (m < 3 ? rb[m < 3 ? m + 1 : 3] : hnv);
                            ag[bj][m][0] = w0a * bflo(pv) + w1a * bflo(cv[m]) + w2a * bflo(nv) + bba;
                            ag[bj][m][1] = w0b * bfhi(pv) + w1b * bfhi(cv[m]) + w2b * bfhi(nv) + bbb;
                        }
                    }
#pragma unroll
                    for (int m = 0; m < 4; ++m) {
                        const float r0 = ag[0][m][0] * ag[1][m][0] * rcp_nr(1.0f + fminf(__expf(-ag[1][m][0]), 1e30f)), r1 = ag[0][m][1] * ag[1][m][1] * rcp_nr(1.0f + fminf(__expf(-ag[1][m][1]), 1e30f));
                        outp[m][2 * n + jp] = pk2(r0, r1);
                    }
                }
            }
#pragma unroll
            for (int m = 0; m < 4; ++m) {
                const int rt = 128 * ai + 64 * wr + 16 * m + fr, sr = sr0 + rt;
                if (rt >= 1 && rt <= 254 && sr < L) { u32x4 o; o.x = outp[m][0]; o.y = outp[m][1]; o.z = outp[m][2]; o.w = outp[m][3]; *(u32x4*)(act + (size_t)(sb + sr) * DFF + u.b0 + cl) = o; }
            }
        }
    }
};

__device__ __forceinline__ void unpack16(const u32x4& a, const u32x4& b, float (&x)[16]) {
    x[0] = bflo(a.x); x[1] = bfhi(a.x); x[2] = bflo(a.y); x[3] = bfhi(a.y); x[4] = bflo(a.z); x[5] = bfhi(a.z); x[6] = bflo(a.w); x[7] = bfhi(a.w);
    x[8] = bflo(b.x); x[9] = bfhi(b.x); x[10] = bflo(b.y); x[11] = bfhi(b.y); x[12] = bflo(b.z); x[13] = bfhi(b.z); x[14] = bflo(b.w); x[15] = bfhi(b.w);
}
__device__ __forceinline__ void qk_prep_store(u32x4 a, u32x4 b, const float* gain, int sub, int pos, float scale, bf16_t* dst, int lane) {
    float x[16]; unpack16(a, b, x);
    float ss = 0.f;
#pragma unroll
    for (int i = 0; i < 16; ++i) ss += x[i] * x[i];
    ss += shx(ss, 1, lane); ss += shx(ss, 2, lane);
    const float r = rsqrtf(ss * (1.0f / 64.0f) + EPS);
#pragma unroll
    for (int i = 0; i < 16; ++i) x[i] = x[i] * r * gain[sub * 16 + i];
    if (sub == 0) {
        const float ihi[8] = {(float)(1.0 / 3.14159265358979323846), (float)(0.19392274474868576 / 3.14159265358979323846), (float)(0.03760603093086393 / 3.14159265358979323846), (float)(0.007292664737217109 / 3.14159265358979323846),
                              (float)(0.001414213562373095 / 3.14159265358979323846), (float)(0.0002742481756762073 / 3.14159265358979323846), (float)(5.318295896944988e-05 / 3.14159265358979323846), (float)(1.031338537721246e-05 / 3.14159265358979323846)};
        const float ilo[8] = {(float)(1.0 / 3.14159265358979323846 - (double)(float)(1.0 / 3.14159265358979323846)), (float)(0.19392274474868576 / 3.14159265358979323846 - (double)(float)(0.19392274474868576 / 3.14159265358979323846)),
                              (float)(0.03760603093086393 / 3.14159265358979323846 - (double)(float)(0.03760603093086393 / 3.14159265358979323846)), (float)(0.007292664737217109 / 3.14159265358979323846 - (double)(float)(0.007292664737217109 / 3.14159265358979323846)),
                              (float)(0.001414213562373095 / 3.14159265358979323846 - (double)(float)(0.001414213562373095 / 3.14159265358979323846)), (float)(0.0002742481756762073 / 3.14159265358979323846 - (double)(float)(0.0002742481756762073 / 3.14159265358979323846)),
                              (float)(5.318295896944988e-05 / 3.14159265358979323846 - (double)(float)(5.318295896944988e-05 / 3.14159265358979323846)), (float)(1.031338537721246e-05 / 3.14159265358979323846 - (double)(float)(1.031338537721246e-05 / 3.14159265358979323846))};
#pragma unroll
        for (int j = 0; j < 8; ++j) {
            const float fp = (float)pos, ph = fp * ihi[j], pe = __builtin_fmaf(fp, ihi[j], -ph) + fp * ilo[j];
            const float red = (ph - 2.0f * rintf(0.5f * ph)) + pe;
            const float2 cs = twid(0.5f * red); const float c = cs.x, s = cs.y;
            const float x1 = x[j], x2 = x[8 + j];
            x[j] = x1 * c - x2 * s; x[8 + j] = x2 * c + x1 * s;
        }
    }
    u32x4 o0, o1;
    o0.x = pk2(x[0] * scale, x[1] * scale); o0.y = pk2(x[2] * scale, x[3] * scale); o0.z = pk2(x[4] * scale, x[5] * scale); o0.w = pk2(x[6] * scale, x[7] * scale);
    o1.x = pk2(x[8] * scale, x[9] * scale); o1.y = pk2(x[10] * scale, x[11] * scale); o1.z = pk2(x[12] * scale, x[13] * scale); o1.w = pk2(x[14] * scale, x[15] * scale);
    *(u32x4*)dst = o0; *(u32x4*)(dst + 8) = o1;
}

__device__ __forceinline__ void ph_attn(KP p, int l, unsigned char* sm, int wv) {
    bf16_t* Ks = (bf16_t*)sm;
    bf16_t* Vt = (bf16_t*)(sm + 57600);
    bf16_t* Qs = (bf16_t*)(sm + 57600 + 51712);
    const bf16_t* Z = p->ZA;
    const int tid = otid(wv), wid = tid >> 6, lane = tid & 63, fr = lane & 15, fq = lane >> 4;
    const float* qg = p->q_norm + l * 64; const float* kg = p->k_norm + l * 64;
    for (int item0 = obid(); item0 < 768; item0 += ogrid()) {
        const int item = ogrid() == 256 ? (item0 & 7) * 96 + (item0 >> 8) * 32 + ((item0 & 255) >> 3) : item0;
        const int kvh = item / 384, qb = item - kvh * 384, Q0 = qb * 128;
        int sbase, L; seq_of(Q0, sbase, L);
        const int Q0rel = Q0 - sbase;
        const bool interior = Q0rel >= 128 && Q0rel + 256 <= L;
        __syncthreads();
        {
            u32x4 ka[4], kb[4], va[4], vb[4];
#pragma unroll
            for (int it = 0; it < 4; ++it) {
                const int idx = tid + 512 * it, row = idx >> 2, sub = idx & 3, prel = Q0rel - 128 + row;
                const bool inb = idx < 1600 && row < 384 && prel >= 0 && prel < L;
                ka[it] = (u32x4){0u, 0u, 0u, 0u}; kb[it] = ka[it]; va[it] = ka[it]; vb[it] = ka[it];
                if (inb) {
                    const bf16_t* src = Z + (size_t)(sbase + prel) * DIN + 512 + kvh * 64 + sub * 16;
                    ka[it] = *(const u32x4*)src; kb[it] = *(const u32x4*)(src + 8);
                    va[it] = *(const u32x4*)(src + 128); vb[it] = *(const u32x4*)(src + 136);
                }
            }
#pragma unroll
            for (int it = 0; it < 4; ++it) {
                const int idx = tid + 512 * it, row = idx >> 2, sub = idx & 3, prel = Q0rel - 128 + row;
                if (idx < 1600) {
                    qk_prep_store(ka[it], kb[it], kg, sub, prel, 1.0f, Ks + row * 72 + sub * 16, lane);
                    const unsigned vv[8] = {va[it].x, va[it].y, va[it].z, va[it].w, vb[it].x, vb[it].y, vb[it].z, vb[it].w};
#pragma unroll
                    for (int i = 0; i < 8; ++i) {
                        Vt[(sub * 16 + 2 * i) * 404 + row] = (bf16_t)(vv[i] & 0xffffu);
                        Vt[(sub * 16 + 2 * i + 1) * 404 + row] = (bf16_t)(vv[i] >> 16);
                    }
                }
            }
        }
        u32x4 qa[4], qb2[4];
#pragma unroll
        for (int g = 0; g < 4; ++g) {
            const bf16_t* src = Z + (size_t)(Q0 + (tid >> 2)) * DIN + (kvh * 4 + g) * 64 + (tid & 3) * 16;
            qa[g] = *(const u32x4*)src; qb2[g] = *(const u32x4*)(src + 8);
        }
        for (int g = 0; g < 4; ++g) {
            const int h = kvh * 4 + g;
            __syncthreads();
            {
                const int row = tid >> 2, sub = tid & 3;
                const u32x4 qsa = g == 0 ? qa[0] : (g == 1 ? qa[1] : (g == 2 ? qa[2] : qa[3])), qsb = g == 0 ? qb2[0] : (g == 1 ? qb2[1] : (g == 2 ? qb2[2] : qb2[3]));
                qk_prep_store(qsa, qsb, qg, sub, Q0rel + row, 0.125f * 1.4426950408889634f, Qs + row * 72 + sub * 16, lane);
            }
            __syncthreads();
            bf16x8 qf[2];
#pragma unroll
            for (int ks = 0; ks < 2; ++ks) qf[ks] = *(const bf16x8*)(Qs + (16 * wid + fr) * 72 + 32 * ks + 8 * fq);
            f32x4 o[4];
#pragma unroll
            for (int dt = 0; dt < 4; ++dt) o[dt] = (f32x4){0.f, 0.f, 0.f, 0.f};
            float mrun = p->sink[l * 8 + h] * 1.4426950408889634f;
            float lsum = fq == 0 ? 1.0f : 0.0f;
            const int qi = 16 * wid + fr;
            for (int s = 0; s < 9; ++s) {
                const int kk0 = 16 * wid + 32 * s;
                f32x4 st[2];
#pragma unroll
                for (int kt = 0; kt < 2; ++kt) {
                    st[kt] = (f32x4){0.f, 0.f, 0.f, 0.f};
#pragma unroll
                    for (int ks = 0; ks < 2; ++ks) {
                        const bf16x8 kf = *(const bf16x8*)(Ks + (kk0 + 16 * kt + fr) * 72 + 32 * ks + 8 * fq);
                        st[kt] = __builtin_amdgcn_mfma_f32_16x16x32_bf16(kf, qf[ks], st[kt], 0, 0, 0);
                    }
                }
                float sv[2][4]; float mx = -1e30f;
                if (interior && s >= 1 && s <= 7) {
#pragma unroll
                    for (int kt = 0; kt < 2; ++kt)
#pragma unroll
                        for (int r = 0; r < 4; ++r) { sv[kt][r] = st[kt][r]; mx = fmaxf(mx, sv[kt][r]); }
                } else {
#pragma unroll
                    for (int kt = 0; kt < 2; ++kt)
#pragma unroll
                        for (int r = 0; r < 4; ++r) {
                            const int kk = kk0 + 16 * kt + 4 * fq + r, d = kk - 128 - qi, prel = Q0rel + kk - 128;
                            const bool valid = d >= -128 && d <= 128 && prel >= 0 && prel < L && kk < 384;
                            sv[kt][r] = valid ? st[kt][r] : -1e30f;
                            mx = fmaxf(mx, sv[kt][r]);
                        }
                }
                mx = fmaxf(mx, shx(mx, 16, lane)); mx = fmaxf(mx, shx(mx, 32, lane));
                const float mn = fmaxf(mrun, mx), alpha = __builtin_amdgcn_exp2f(mrun - mn);
                mrun = mn;
                float pr[2][4], psum = 0.f;
#pragma unroll
                for (int kt = 0; kt < 2; ++kt)
#pragma unroll
                    for (int r = 0; r < 4; ++r) { pr[kt][r] = __builtin_amdgcn_exp2f(sv[kt][r] - mn); psum += pr[kt][r]; }
                lsum = lsum * alpha + psum;
                union { bf16x8 v; unsigned u[4]; } pf;
                pf.u[0] = pk2(pr[0][0], pr[0][1]); pf.u[1] = pk2(pr[0][2], pr[0][3]); pf.u[2] = pk2(pr[1][0], pr[1][1]); pf.u[3] = pk2(pr[1][2], pr[1][3]);
#pragma unroll
                for (int dt = 0; dt < 4; ++dt) {
                    o[dt] = o[dt] * alpha;
                    union { bf16x8 v; u32x2 h[2]; } vf;
                    vf.h[0] = *(const u32x2*)(Vt + (16 * dt + fr) * 404 + kk0 + 4 * fq);
                    vf.h[1] = *(const u32x2*)(Vt + (16 * dt + fr) * 404 + kk0 + 16 + 4 * fq);
                    o[dt] = __builtin_amdgcn_mfma_f32_16x16x32_bf16(vf.v, pf.v, o[dt], 0, 0, 0);
                }
            }
            lsum += shx(lsum, 16, lane); lsum += shx(lsum, 32, lane);
            const float il = frcp(lsum);
            bf16_t* dst = p->Y + (size_t)(Q0 + qi) * DM + h * 64 + 4 * fq;
#pragma unroll
            for (int dt = 0; dt < 4; ++dt) { u32x2 w; w.x = pk2(o[dt].x * il, o[dt].y * il); w.y = pk2(o[dt].z * il, o[dt].w * il); *(u32x2*)(dst + 16 * dt) = w; }
        }
    }
}

__device__ __forceinline__ void ph_hyena_pre(KP p, int l, unsigned char* sm, int wv) {
    constexpr int ZS = 513;
    unsigned* zt = (unsigned*)sm;
    bf16_t* vt = (bf16_t*)(sm + 34 * ZS * 4);
    float* cw = (float*)(sm + 34 * ZS * 4 + 512 * 80);
    const bf16_t* Z = p->ZA;
    const int tid = otid(wv), tt = tid & 31, cg = tid >> 5;
    const float* ws = p->w_short + (size_t)l * 3 * 1536; const float* bs = p->b_short + l * 1536;
    __syncthreads();
    cw[tid] = ws[512 + tid]; cw[512 + tid] = ws[1536 + 512 + tid]; cw[1024 + tid] = ws[3072 + 512 + tid]; cw[1536 + tid] = bs[512 + tid];
    cw[2048 + tid] = ws[1024 + tid]; cw[2560 + tid] = ws[1536 + 1024 + tid]; cw[3072 + tid] = ws[3072 + 1024 + tid]; cw[3584 + tid] = bs[1024 + tid];
    u32x4 pre[9];
    {
        const int t0 = obid() * 32; int sbase, L; seq_of(t0, sbase, L);
#pragma unroll
        for (int i = 0; i < 9; ++i) {
            const int q = tid + 512 * i, r = q >> 7, ch = q & 127, t = t0 - 1 + r;
            pre[i] = (u32x4){0u, 0u, 0u, 0u};
            if (q < 34 * 128 && t >= sbase && t < sbase + L) pre[i] = *(const u32x4*)(Z + (size_t)t * DIN + 1280 + ch * 8);
        }
    }
    for (int tile = obid(); tile < 1536; tile += ogrid()) {
        const int t0 = tile * 32;
        __syncthreads();
#pragma unroll
        for (int i = 0; i < 9; ++i) {
            const int q = tid + 512 * i, r = q >> 7, ch = q & 127;
            if (q < 34 * 128) { unsigned* d = zt + r * ZS + ch * 4; d[0] = pre[i].x; d[1] = pre[i].y; d[2] = pre[i].z; d[3] = pre[i].w; }
        }
        __syncthreads();
        {
            const int tn = tile + ogrid();
            if (tn < 1536) {
                const int t0n = tn * 32; int sbn, Ln; seq_of(t0n, sbn, Ln);
#pragma unroll
                for (int i = 0; i < 9; ++i) {
                    const int q = tid + 512 * i, r = q >> 7, ch = q & 127, t = t0n - 1 + r;
                    pre[i] = (u32x4){0u, 0u, 0u, 0u};
                    if (q < 34 * 128 && t >= sbn && t < sbn + Ln) pre[i] = *(const u32x4*)(Z + (size_t)t * DIN + 1280 + ch * 8);
                }
            }
        }
#pragma unroll 4
        for (int i = 0; i < 16; ++i) {
            const int c = cg * 32 + 2 * i;
            const unsigned a_p = zt[tt * ZS + (c >> 1)], a_c = zt[(tt + 1) * ZS + (c >> 1)], a_n = zt[(tt + 2) * ZS + (c >> 1)];
            const unsigned g_p = zt[tt * ZS + 256 + (c >> 1)], g_c = zt[(tt + 1) * ZS + 256 + (c >> 1)], g_n = zt[(tt + 2) * ZS + 256 + (c >> 1)];
            const float u1a = cw[c] * bflo(a_p) + cw[512 + c] * bflo(a_c) + cw[1024 + c] * bflo(a_n) + cw[1536 + c];
            const float u2a = cw[2048 + c] * bflo(g_p) + cw[2560 + c] * bflo(g_c) + cw[3072 + c] * bflo(g_n) + cw[3584 + c];
            const float u1b = cw[c + 1] * bfhi(a_p) + cw[513 + c] * bfhi(a_c) + cw[1025 + c] * bfhi(a_n) + cw[1537 + c];
            const float u2b = cw[2049 + c] * bfhi(g_p) + cw[2561 + c] * bfhi(g_c) + cw[3073 + c] * bfhi(g_n) + cw[3585 + c];
            const unsigned pk = pk2(u1a * u2a, u1b * u2b);
            vt[c * 40 + tt] = (bf16_t)(pk & 0xffffu); vt[(c + 1) * 40 + tt] = (bf16_t)(pk >> 16);
        }
        __syncthreads();
#pragma unroll
        for (int i = 0; i < 4; ++i) {
            const int q = tid + 512 * i, cc = q >> 2, part = q & 3;
            *(u32x4*)(p->V + (size_t)cc * T + t0 + part * 8) = *(const u32x4*)(vt + cc * 40 + part * 8);
        }
    }
}

__device__ __forceinline__ void ph_filtergen(KP p, int l, unsigned char* sm, int wv) {
    float* zf = (float*)sm;
    float* h1 = zf + 64 * 34;
    float* h2 = h1 + 64 * 65;
    float* w1s = h2 + 64 * 68;
    float* w2s = w1s + 33 * 64;
    float* ot = w2s + 64 * 64;
    const int tid = otid(wv), wid = tid >> 6, lane = tid & 63;
    const float* b1 = p->fb1 + l * 64; const float* f1 = p->ffr1 + l * 64;
    const float* b2 = p->fb2 + l * 64; const float* f2 = p->ffr2 + l * 64;
    const float* w3 = p->fw3 + (size_t)l * 65536; const float* hb = p->hbias + l * 512;
    __syncthreads();
    for (int i = tid; i < 33 * 64; i += 512) w1s[i] = p->fw1[l * 33 * 64 + i];
    for (int i = tid; i < 64 * 64; i += 512) w2s[i] = p->fw2[l * 4096 + i];
    for (int item = obid(); item < 384; item += ogrid()) {
        const int L = item < 256 ? LP : LSQ, n0 = (item < 256 ? item : item - 256) * 64;
        bf16_t* kf = p->X + (item < 256 ? 0 : 16777216);
        __syncthreads();
        {
            const int n = n0 + lane;
            const float w = 2.0f * (float)n / (float)L;
#pragma unroll
            for (int q = 0; q < 2; ++q) {
                const int b = wid * 2 + q;
                const float f = 1e-4f + (float)b * 0.9999933333333334f;
                const float ht = f * w, red = ht - 2.0f * rintf(0.5f * ht);
                const float2 cs = twid_precise(0.5f * red);
                zf[lane * 34 + 1 + b] = cs.x; zf[lane * 34 + 17 + b] = -cs.y;
            }
            if (wid == 0) zf[lane * 34] = (float)n / (float)(L - 1);
        }
        __syncthreads();
        {
            float a[8];
#pragma unroll
            for (int i = 0; i < 8; ++i) a[i] = b1[wid * 8 + i];
#pragma unroll 3
            for (int f = 0; f < 33; ++f) {
                const float zv = zf[lane * 34 + f];
                const f32x4 w0 = *(const f32x4*)(w1s + f * 64 + wid * 8), w1v = *(const f32x4*)(w1s + f * 64 + wid * 8 + 4);
                a[0] += zv * w0.x; a[1] += zv * w0.y; a[2] += zv * w0.z; a[3] += zv * w0.w; a[4] += zv * w1v.x; a[5] += zv * w1v.y; a[6] += zv * w1v.z; a[7] += zv * w1v.w;
            }
#pragma unroll
            for (int i = 0; i < 8; ++i) h1[lane * 65 + wid * 8 + i] = sinpif(f1[wid * 8 + i] * a[i] * 0.3183098861837907f);
        }
        __syncthreads();
        {
            float a[8];
#pragma unroll
            for (int i = 0; i < 8; ++i) a[i] = b2[wid * 8 + i];
#pragma unroll 4
            for (int j = 0; j < 64; ++j) {
                const float zv = h1[lane * 65 + j];
                const f32x4 w0 = *(const f32x4*)(w2s + j * 64 + wid * 8), w1v = *(const f32x4*)(w2s + j * 64 + wid * 8 + 4);
                a[0] += zv * w0.x; a[1] += zv * w0.y; a[2] += zv * w0.z; a[3] += zv * w0.w; a[4] += zv * w1v.x; a[5] += zv * w1v.y; a[6] += zv * w1v.z; a[7] += zv * w1v.w;
            }
#pragma unroll
            for (int i = 0; i < 8; ++i) h2[lane * 68 + wid * 8 + i] = sinpif(f2[wid * 8 + i] * a[i] * 0.3183098861837907f);
        }
        __syncthreads();
#pragma unroll 1
        for (int pass = 0; pass < 4; ++pass) {
            const int ol = tid & 255, o = pass * 256 + ol, ph0 = (tid >> 8) * 32;
            float wcol[64];
#pragma unroll
            for (int j = 0; j < 64; ++j) wcol[j] = w3[j * 1024 + o];
#pragma unroll 2
            for (int pp = 0; pp < 32; ++pp) {
                const f32x4* hr = (const f32x4*)(h2 + (ph0 + pp) * 68);
                float acc0 = 0.f, acc1 = 0.f;
#pragma unroll
                for (int j4 = 0; j4 < 16; ++j4) { const f32x4 hv = hr[j4]; acc0 += hv.x * wcol[j4 * 4] + hv.z * wcol[j4 * 4 + 2]; acc1 += hv.y * wcol[j4 * 4 + 1] + hv.w * wcol[j4 * 4 + 3]; }
                ot[ol * 65 + ph0 + pp] = acc0 + acc1;
            }
            __syncthreads();
            for (int e = tid; e < 256 * 64; e += 512) {
                const int ol2 = e >> 6, pos = e & 63, o2 = pass * 256 + ol2, c = o2 & 511, n = n0 + pos;
                const float tt = (float)n / (float)(L - 1);
                const float delta = fabsf(-3.070113457325394f + (float)c * ((-15.350567286626971f + 3.070113457325394f) / 511.0f));
                float val = ot[ol2 * 65 + pos] * __expf(-tt * delta);
                bf16_t* kc = kf + (size_t)c * (2 * L);
                if (o2 < 512) { if (n == 0) val += hb[c]; kc[n] = (bf16_t)(pk2(val, 0.f) & 0xffffu); }
                else { if (n >= 1) kc[2 * L - n] = (bf16_t)(pk2(val, 0.f) & 0xffffu); else kc[L] = (bf16_t)0; }
            }
            __syncthreads();
        }
    }
}

__device__ __forceinline__ float2 cmul(float2 a, float2 b) { return make_float2(a.x * b.x - a.y * b.y, a.x * b.y + a.y * b.x); }
__device__ __forceinline__ float2 cadd(float2 a, float2 b) { return make_float2(a.x + b.x, a.y + b.y); }
__device__ __forceinline__ float2 csub(float2 a, float2 b) { return make_float2(a.x - b.x, a.y - b.y); }

__device__ __forceinline__ int PD(int i) { return i + (i >> 4); }
template <bool TW>
__device__ __forceinline__ void fft16_fwd(float2 (&x)[16], float2 T1) {
    const float C[8] = {1.0f, 0.92387953251128674f, 0.70710678118654752f, 0.38268343236508977f, 0.0f, -0.38268343236508977f, -0.70710678118654752f, -0.92387953251128674f};
    const float S[8] = {0.0f, 0.38268343236508977f, 0.70710678118654752f, 0.92387953251128674f, 1.0f, 0.92387953251128674f, 0.70710678118654752f, 0.38268343236508977f};
    float2 Ts = T1;
#pragma unroll
    for (int st = 0; st < 4; ++st) {
        const int half = 8 >> st;
#pragma unroll
        for (int i = 0; i < 8; ++i) {
            const int g = i / half, j = i % half, pp = g * 2 * half + j, ti = j * (8 / half);
            const float2 a = x[pp], b = x[pp + half], d = csub(a, b);
            x[pp] = cadd(a, b);
            const float2 dw = cmul(d, make_float2(C[ti], -S[ti]));
            x[pp + half] = TW ? cmul(dw, Ts) : dw;
        }
        if (TW) Ts = cmul(Ts, Ts);
    }
}
template <bool TW>
__device__ __forceinline__ void fft16_inv(float2 (&x)[16], float2 T1c) {
    const float C[8] = {1.0f, 0.92387953251128674f, 0.70710678118654752f, 0.38268343236508977f, 0.0f, -0.38268343236508977f, -0.70710678118654752f, -0.92387953251128674f};
    const float S[8] = {0.0f, 0.38268343236508977f, 0.70710678118654752f, 0.92387953251128674f, 1.0f, 0.92387953251128674f, 0.70710678118654752f, 0.38268343236508977f};
    const float2 T2 = cmul(T1c, T1c), T4 = cmul(T2, T2), T8 = cmul(T4, T4);
#pragma unroll
    for (int st = 0; st < 4; ++st) {
        const int half = 1 << st;
        const float2 Ts = st == 0 ? T8 : (st == 1 ? T4 : (st == 2 ? T2 : T1c));
#pragma unroll
        for (int i = 0; i < 8; ++i) {
            const int g = i / half, j = i % half, pp = g * 2 * half + j, ti = j * (8 / half);
            const float2 bw = cmul(x[pp + half], make_float2(C[ti], S[ti]));
            const float2 a = x[pp], b = TW ? cmul(bw, Ts) : bw;
            x[pp] = cadd(a, b); x[pp + half] = csub(a, b);
        }
    }
}
template <bool FWD>
__device__ __forceinline__ void fft_pass16(float2* z, int Lc, int ls, int tid) {
    const int s = 1 << ls, os = ls >= 4 ? s + (s >> 4) : 1;
    const float its = 0.0625f / (float)s;
    for (int q = tid; q < (Lc >> 4); q += 512) {
        const int g = q >> ls, j = q & (s - 1), pb = PD((g << (ls + 4)) + j);
        float2 x[16];
#pragma unroll
        for (int k = 0; k < 16; ++k) x[k] = z[pb + k * os];
        if (ls == 0) { if (FWD) fft16_fwd<false>(x, make_float2(1.f, 0.f)); else fft16_inv<false>(x, make_float2(1.f, 0.f)); }
        else { const float2 T1 = twid((FWD ? -1.0f : 1.0f) * (float)j * its); if (FWD) fft16_fwd<true>(x, T1); else fft16_inv<true>(x, T1); }
#pragma unroll
        for (int k = 0; k < 16; ++k) z[pb + k * os] = x[k];
    }
    __syncthreads();
}
__device__ __forceinline__ void fft_fwd(float2* z, int lg, int tid) {
    const int Lc = 1 << lg; const int lh = lg - 1;
    if (lg & 1) {
        const int h = 1 << lh, oh = h + (h >> 4);
        for (int j = tid; j < h; j += 512) {
            const int pj = PD(j);
            const float2 a = z[pj], b = z[pj + oh];
            z[pj] = cadd(a, b); z[pj + oh] = cmul(csub(a, b), twid(-(float)j * (0.5f / (float)h)));
        }
        __syncthreads();
    } else {
        const int h = 1 << lh, hh = h >> 1, oh = h + (h >> 4), ohh = hh + (hh >> 4);
        const float ih2 = 0.5f / (float)h;
        for (int q0 = tid; q0 < (Lc >> 2); q0 += 2048) {
            float2 x[4][4]; int pbs[4]; float2 w1s[4];
#pragma unroll
            for (int u = 0; u < 4; ++u) {
                const int q = q0 + 512 * u, g = q >> (lh - 1), j = q & (hh - 1), pb = PD((g << (lh + 1)) + j);
                pbs[u] = pb; w1s[u] = twid(-(float)j * ih2);
                x[u][0] = z[pb]; x[u][1] = z[pb + ohh]; x[u][2] = z[pb + oh]; x[u][3] = z[pb + oh + ohh];
            }
#pragma unroll
            for (int u = 0; u < 4; ++u) {
                const float2 w1 = w1s[u], w2 = cmul(w1, w1);
                const float2 a0 = cadd(x[u][0], x[u][2]), a2 = cmul(csub(x[u][0], x[u][2]), w1), a1 = cadd(x[u][1], x[u][3]), t3 = cmul(csub(x[u][1], x[u][3]), w1);
                const float2 a3 = make_float2(t3.y, -t3.x);
                x[u][0] = cadd(a0, a1); x[u][1] = cmul(csub(a0, a1), w2); x[u][2] = cadd(a2, a3); x[u][3] = cmul(csub(a2, a3), w2);
            }
#pragma unroll
            for (int u = 0; u < 4; ++u) { const int pb = pbs[u]; z[pb] = x[u][0]; z[pb + ohh] = x[u][1]; z[pb + oh] = x[u][2]; z[pb + oh + ohh] = x[u][3]; }
        }
        __syncthreads();
    }
    fft_pass16<true>(z, Lc, 8, tid);
    fft_pass16<true>(z, Lc, 4, tid);
    fft_pass16<true>(z, Lc, 0, tid);
}
__device__ __forceinline__ void fft_inv(float2* z, int lg, int tid) {
    const int Lc = 1 << lg; const int lh = 12;
    fft_pass16<false>(z, Lc, 0, tid);
    fft_pass16<false>(z, Lc, 4, tid);
    fft_pass16<false>(z, Lc, 8, tid);
    if (lg & 1) {
        const int h = 1 << lh, oh = h + (h >> 4);
        for (int j = tid; j < h; j += 512) {
            const int pj = PD(j);
            const float2 a = z[pj], b = cmul(z[pj + oh], twid((float)j * (0.5f / (float)h)));
            z[pj] = cadd(a, b); z[pj + oh] = csub(a, b);
        }
        __syncthreads();
    } else {
        const int h = 1 << lh, oh = h + (h >> 4);
        const float ih4 = 0.25f / (float)h;
        for (int q0 = tid; q0 < (Lc >> 2); q0 += 2048) {
            float2 x[4][4]; int pbs[4]; float2 cws[4];
#pragma unroll
            for (int u = 0; u < 4; ++u) {
                const int q = q0 + 512 * u, g = q >> lh, j = q & (h - 1), pb = PD((g << (lh + 2)) + j);
                pbs[u] = pb; cws[u] = twid((float)j * ih4);
                x[u][0] = z[pb]; x[u][1] = z[pb + oh]; x[u][2] = z[pb + 2 * oh]; x[u][3] = z[pb + 3 * oh];
            }
#pragma unroll
            for (int u = 0; u < 4; ++u) {
                const float2 cwb = cws[u], cwa = cmul(cwb, cwb);
                const float2 t1 = cmul(x[u][1], cwa), a0 = cadd(x[u][0], t1), a1 = csub(x[u][0], t1), t3 = cmul(x[u][3], cwa), a2 = cadd(x[u][2], t3), a3 = csub(x[u][2], t3);
                const float2 u2 = cmul(a2, cwb), u3t = cmul(a3, cwb), u3 = make_float2(-u3t.y, u3t.x);
                x[u][0] = cadd(a0, u2); x[u][2] = csub(a0, u2); x[u][1] = cadd(a1, u3); x[u][3] = csub(a1, u3);
            }
#pragma unroll
            for (int u = 0; u < 4; ++u) { const int pb = pbs[u]; z[pb] = x[u][0]; z[pb + oh] = x[u][1]; z[pb + 2 * oh] = x[u][2]; z[pb + 3 * oh] = x[u][3]; }
        }
        __syncthreads();
    }
}

__device__ __forceinline__ void ph_filter_fft(KP p, unsigned char* sm, int wv) {
    float2* z = (float2*)sm;
    const int tid = otid(wv);
    for (int item = obid(); item < 1024; item += ogrid()) {
        const int big = item < 512, c = item & 511, lg = big ? 14 : 13, Lc = 1 << lg;
        unsigned* g = (unsigned*)p->X + (big ? 0 : 8388608) + (size_t)c * Lc;
        __syncthreads();
#pragma unroll 4
        for (int i = tid; i < (Lc >> 2); i += 512) {
            const u32x4 v = *(const u32x4*)(g + 4 * i); const int pi = PD(4 * i);
            z[pi] = make_float2(bflo(v.x), bfhi(v.x)); z[pi + 1] = make_float2(bflo(v.y), bfhi(v.y)); z[pi + 2] = make_float2(bflo(v.z), bfhi(v.z)); z[pi + 3] = make_float2(bflo(v.w), bfhi(v.w));
        }
        __syncthreads();
        fft_fwd(z, lg, tid);
        const float sc = 1.0f / (float)Lc;
        for (int k = tid; k <= (Lc >> 1); k += 512) {
            if (k == 0) { const float2 Z0 = z[0]; g[0] = pk2((Z0.x + Z0.y) * sc, (Z0.x - Z0.y) * sc); continue; }
            const int pk = (int)(__brev((unsigned)k) >> (32 - lg)), pm = (int)(__brev((unsigned)(Lc - k)) >> (32 - lg));
            const float2 Zk = z[PD(pk)], Zm = z[PD(pm)];
            const float2 E = make_float2(0.5f * (Zk.x + Zm.x), 0.5f * (Zk.y - Zm.y));
            const float2 O = make_float2(0.5f * (Zk.y + Zm.y), -0.5f * (Zk.x - Zm.x));
            const float2 wO = cmul(twid(-(float)k * (0.5f / (float)Lc)), O);
            const float2 Xk = cadd(E, wO), Xm0 = csub(E, wO);
            g[k] = pk2(Xk.x * sc, Xk.y * sc);
            g[Lc - k] = pk2(Xm0.x * sc, -Xm0.y * sc);
        }
    }
}

template <int LG>
__device__ __forceinline__ void pair_one(float2* z, int k, float2 Kk, float2 Km) {
    constexpr int Lc = 1 << LG;
    const int pk = (int)(__brev((unsigned)k) >> (32 - LG)), pm = (int)(__brev((unsigned)(Lc - k)) >> (32 - LG));
    const float2 Zk = z[PD(pk)], Zm = z[PD(pm)];
    const float2 E = make_float2(0.5f * (Zk.x + Zm.x), 0.5f * (Zk.y - Zm.y));
    const float2 O = make_float2(0.5f * (Zk.y + Zm.y), -0.5f * (Zk.x - Zm.x));
    const float2 w = twid(-(float)k * (0.5f / (float)Lc));
    const float2 wO = cmul(w, O);
    const float2 Xk = cadd(E, wO), Xm0 = csub(E, wO), Xm = make_float2(Xm0.x, -Xm0.y);
    const float2 Yk = cmul(Xk, Kk), Ym = cmul(Xm, Km);
    const float2 E2 = make_float2(0.5f * (Yk.x + Ym.x), 0.5f * (Yk.y - Ym.y));
    const float2 D2 = make_float2(0.5f * (Yk.x - Ym.x), 0.5f * (Yk.y + Ym.y));
    const float2 O2 = cmul(D2, make_float2(w.x, -w.y));
    z[PD(pk)] = make_float2(E2.x - O2.y, E2.y + O2.x);
    if (pm != pk) z[PD(pm)] = make_float2(E2.x + O2.y, -E2.y + O2.x);
}
template <int LG, int NSEQ>
__device__ __forceinline__ void fftconv_channel(float2* z, const unsigned* spec, bf16_t* v0, int tid0) {
    constexpr int Lc = 1 << LG, NK = Lc / 1024, NL = Lc / 4096;
    unsigned sku[NK], smu[NK];
#pragma unroll
    for (int i = 0; i < NK; ++i) { const int k = tid0 + 512 * i; sku[i] = spec[k]; smu[i] = spec[(Lc - k) & (Lc - 1)]; }
    const unsigned shu = spec[Lc >> 1];
#pragma unroll 1
    for (int sq = 0; sq < NSEQ; ++sq) {
        int tid = tid0; asm volatile("" : "+v"(tid));
        bf16_t* v = v0 + (size_t)sq * Lc;
        u32x4 raw[NL];
#pragma unroll
        for (int i = 0; i < NL; ++i) raw[i] = *(const u32x4*)(v + 8 * (tid + 512 * i));
        __syncthreads();
#pragma unroll
        for (int i = 0; i < NL; ++i) {
            const int pi = PD(4 * (tid + 512 * i));
            z[pi] = make_float2(bflo(raw[i].x), bfhi(raw[i].x)); z[pi + 1] = make_float2(bflo(raw[i].y), bfhi(raw[i].y));
            z[pi + 2] = make_float2(bflo(raw[i].z), bfhi(raw[i].z)); z[pi + 3] = make_float2(bflo(raw[i].w), bfhi(raw[i].w));
        }
        for (int i = (Lc >> 1) + tid; i < Lc; i += 512) z[PD(i)] = make_float2(0.f, 0.f);
        int lgv = LG; asm volatile("" : "+s"(lgv));
        __syncthreads();
        fft_fwd(z, lgv, tid);
#pragma unroll
        for (int i = 0; i < NK; ++i) {
            int tz = 0; asm volatile("" : "+v"(tz));
            const int k = tid + tz + 512 * i;
            if (k == 0) { const float2 Z0 = z[0], K0 = make_float2(bflo(sku[0]), bfhi(sku[0])); const float Y0 = (Z0.x + Z0.y) * K0.x, YL = (Z0.x - Z0.y) * K0.y; z[0] = make_float2(0.5f * (Y0 + YL), 0.5f * (Y0 - YL)); }
            else pair_one<LG>(z, k, make_float2(bflo(sku[i]), bfhi(sku[i])), make_float2(bflo(smu[i]), bfhi(smu[i])));
        }
        if (tid == 0) pair_one<LG>(z, Lc >> 1, make_float2(bflo(shu), bfhi(shu)), make_float2(bflo(shu), bfhi(shu)));
        __syncthreads();
        fft_inv(z, lgv, tid);
#pragma unroll
        for (int i = 0; i < NL; ++i) {
            const int pi = PD(4 * (tid + 512 * i)); const float2 a = z[pi], b = z[pi + 1], cc = z[pi + 2], d = z[pi + 3];
            u32x4 o; o.x = pk2(a.x, a.y); o.y = pk2(b.x, b.y); o.z = pk2(cc.x, cc.y); o.w = pk2(d.x, d.y);
            *(u32x4*)(v + 8 * (tid + 512 * i)) = o;
        }
    }
}
__device__ __forceinline__ void ph_fftconv(KP p, unsigned char* sm, int wv) {
    float2* z = (float2*)sm;
    const int tid0 = otid(wv);
    for (int c = obid(); c < 512; c += ogrid()) {
        int tid = tid0; asm volatile("" : "+v"(tid));
        fftconv_channel<14, 1>(z, (const unsigned*)p->X + (size_t)c * 16384, p->V + (size_t)c * T, tid);
        asm volatile("" : "+v"(tid));
        fftconv_channel<13, 4>(z, (const unsigned*)p->X + 8388608 + (size_t)c * 8192, p->V + (size_t)c * T + LP, tid);
    }
}

__device__ __forceinline__ void ph_mixfinal(KP p, int l, unsigned char* sm, int wv) {
    constexpr int ZS = 257;
    bf16_t* yt = (bf16_t*)sm;
    unsigned* zt = (unsigned*)(sm + 73728);
    float* part = (float*)(sm + 73728 + 66 * ZS * 4);
    float* cw = part + 512;
    const bf16_t* Z = p->ZA;
    const int tid = otid(wv), wid = tid >> 6, lane = tid & 63, tt = lane, cg = wid;
    const float* ws = p->w_short + (size_t)l * 3 * 1536; const float* bs = p->b_short + l * 1536;
    const float* gh = p->nho + l * 512;
    __syncthreads();
    cw[tid] = ws[tid]; cw[512 + tid] = ws[1536 + tid]; cw[1024 + tid] = ws[3072 + tid]; cw[1536 + tid] = bs[tid];
    for (int tile = obid(); tile < 768; tile += ogrid()) {
        const int t0 = tile * 64; int sbase, L; seq_of(t0, sbase, L);
        const int tend = sbase + L;
        u32x4 arow[8];
#pragma unroll
        for (int i = 0; i < 8; ++i) arow[i] = *(const u32x4*)(p->Y + (size_t)(t0 + wid * 8 + i) * DM + lane * 8);
        __syncthreads();
#pragma unroll
        for (int i = 0; i < 8; ++i) {
            const int q = tid + 512 * i, cc = q >> 3, pt = q & 7;
            *(u32x4*)(yt + cc * 72 + pt * 8) = *(const u32x4*)(p->V + (size_t)cc * T + t0 + pt * 8);
        }
        for (int q = tid; q < 66 * 64; q += 512) {
            const int r = q >> 6, ch = q & 63, t = t0 - 1 + r;
            u32x4 v = (u32x4){0u, 0u, 0u, 0u};
            if (t >= sbase && t < tend) v = *(const u32x4*)(Z + (size_t)t * DIN + 768 + ch * 8);
            unsigned* d = zt + r * ZS + ch * 4;
            d[0] = v.x; d[1] = v.y; d[2] = v.z; d[3] = v.w;
        }
        __syncthreads();
        unsigned hyp[32]; float sq = 0.f;
#pragma unroll
        for (int i = 0; i < 32; ++i) {
            const int c = cg * 64 + 2 * i;
            const unsigned z_p = zt[tt * ZS + (c >> 1)], z_c = zt[(tt + 1) * ZS + (c >> 1)], z_n = zt[(tt + 2) * ZS + (c >> 1)];
            const float x0a = cw[c] * bflo(z_p) + cw[512 + c] * bflo(z_c) + cw[1024 + c] * bflo(z_n) + cw[1536 + c];
            const float x0b = cw[c + 1] * bfhi(z_p) + cw[513 + c] * bfhi(z_c) + cw[1025 + c] * bfhi(z_n) + cw[1537 + c];
            const float ha = x0a * bf1(yt[c * 72 + tt]), hb = x0b * bf1(yt[(c + 1) * 72 + tt]);
            sq += ha * ha + hb * hb;
            hyp[i] = pk2(ha, hb);
        }
        part[tt * 8 + cg] = sq;
        __syncthreads();
        {
            const f32x4 q0 = *(const f32x4*)(part + tt * 8), q1 = *(const f32x4*)(part + tt * 8 + 4);
            const float sm_ = ((q0.x + q0.y) + (q0.z + q0.w)) + ((q1.x + q1.y) + (q1.z + q1.w));
            const float r = rsqrtf(sm_ * (1.0f / 512.0f) + EPS);
            bf16_t* dst = p->Y + (size_t)(t0 + tt) * DM + 512 + cg * 64;
#pragma unroll
            for (int i8 = 0; i8 < 8; ++i8) {
                const f32x4 g0 = *(const f32x4*)(gh + cg * 64 + i8 * 8), g1 = *(const f32x4*)(gh + cg * 64 + i8 * 8 + 4);
                u32x4 o;
                o.x = pk2(bflo(hyp[i8 * 4]) * r * g0.x, bfhi(hyp[i8 * 4]) * r * g0.y); o.y = pk2(bflo(hyp[i8 * 4 + 1]) * r * g0.z, bfhi(hyp[i8 * 4 + 1]) * r * g0.w);
                o.z = pk2(bflo(hyp[i8 * 4 + 2]) * r * g1.x, bfhi(hyp[i8 * 4 + 2]) * r * g1.y); o.w = pk2(bflo(hyp[i8 * 4 + 3]) * r * g1.z, bfhi(hyp[i8 * 4 + 3]) * r * g1.w);
                *(u32x4*)(dst + i8 * 8) = o;
            }
        }
        const f32x4 ga0 = *(const f32x4*)(p->nao + l * 512 + lane * 8), ga1 = *(const f32x4*)(p->nao + l * 512 + lane * 8 + 4);
#pragma unroll
        for (int i = 0; i < 8; ++i) {
            const int t = t0 + wid * 8 + i;
            bf16_t* rowp = p->Y + (size_t)t * DM + lane * 8;
            const u32x4 raw = arow[i];
            float x[8] = {bflo(raw.x), bfhi(raw.x), bflo(raw.y), bfhi(raw.y), bflo(raw.z), bfhi(raw.z), bflo(raw.w), bfhi(raw.w)};
            float s = 0.f;
#pragma unroll
            for (int k = 0; k < 8; ++k) s += x[k] * x[k];
            s = wave_sum(s, lane);
            const float r = rsqrtf(s * (1.0f / 512.0f) + EPS);
            u32x4 o; o.x = pk2(x[0] * r * ga0.x, x[1] * r * ga0.y); o.y = pk2(x[2] * r * ga0.z, x[3] * r * ga0.w); o.z = pk2(x[4] * r * ga1.x, x[5] * r * ga1.y); o.w = pk2(x[6] * r * ga1.z, x[7] * r * ga1.w);
            *(u32x4*)rowp = o;
        }
    }
}

enum { OP_XCONV = 0, OP_WCONV, OP_GEMM_IN, OP_FILTERGEN, OP_ATTN, OP_HPRE, OP_FFFT, OP_FFTCONV, OP_MIXFINAL, OP_GEMM_OUT, OP_PCONV, OP_GEMM_UP, OP_GEMM_DOWN, OP_GEMM_GATE, OP_GEMM_PROJ };
__global__ void __launch_bounds__(512, 2) mega(P p_arg) {
    extern __shared__ __attribute__((aligned(16))) unsigned char smem[];
    LAS unsigned char* lds = (LAS unsigned char*)smem;
    const int nseq = p_arg.nseq;
    const int wv = __builtin_amdgcn_readfirstlane((int)(threadIdx.x >> 6));
    for (int si = 0; si < nseq; ++si) {
        KP p = (KP)__builtin_amdgcn_kernarg_segment_ptr();
        asm volatile("" : "+s"(p));
        const int code = __builtin_amdgcn_readfirstlane(p->seq[si]), op = code & 31, l = (code >> 5) & 3;
        const bf16_t* Wl = p->W + (size_t)(l & 1) * W_LAYER;
        if (op == OP_XCONV) ph_xconv(p, wv);
        else if (op == OP_WCONV) ph_wconv(p, l, smem, wv);
        else if (op == OP_GEMM_IN) { Sched S; S.init(192, 9, 0); EpiIn E{p->ZA, p->ss_in}; gemm_phase(lds, l == 0 ? (const bf16_t*)p->Y : (const bf16_t*)p->out, Wl + WO_IN, 1024, S, E, wv); }
        else if (op == OP_FILTERGEN) ph_filtergen(p, l, smem, wv);
        else if (op == OP_ATTN) ph_attn(p, l, smem, wv);
        else if (op == OP_HPRE) ph_hyena_pre(p, l, smem, wv);
        else if (op == OP_FFFT) ph_filter_fft(p, smem, wv);
        else if (op == OP_FFTCONV) ph_fftconv(p, smem, wv);
        else if (op == OP_MIXFINAL) ph_mixfinal(p, l, smem, wv);
        else if (op == OP_GEMM_OUT) { Sched S; S.init(192, 4, 0); EpiRes E{p->xp, p->xs, (const bf16_t*)p->out, p->X, p->ss_ffn, l == 0 ? 0 : 1}; gemm_phase(lds, p->Y, Wl + WO_OUT, 1024, S, E, wv); }
        else if (op == OP_PCONV) ph_pconv(p, l, wv);
        else if (op == OP_GEMM_UP) { Sched S; S.init(197, 22, 1); EpiUp E{p->ZA, p->ss_ffn, p->w_ffconv + (size_t)l * 3 * 5632, p->b_ffconv + (size_t)l * 5632}; gemm_phase(lds, p->X, Wl + WO_UP, 1024, S, E, wv); }
        else if (op == OP_GEMM_DOWN) { Sched S; S.init(192, 4, 0); EpiRes E{p->xp, p->xs, p->X, p->X, nullptr, 1}; gemm_phase(lds, p->ZA, Wl + WO_DOWN, 2816, S, E, wv); }
        else if (op == OP_GEMM_GATE) { Sched S; S.init(192, 4, 0); EpiGate E{p->ZA}; gemm_phase(lds, p->X, Wl + WO_GATE, 1024, S, E, wv); }
        else { Sched S; S.init(192, 4, 0); EpiProj E{p->ZA, p->X, p->out, (bf16_t*)p->out, p->ss_in, l == NLAYER - 1 ? 1 : 0}; gemm_phase(lds, p->V, Wl + WO_PROJ, 256, S, E, wv); }
        if (code & 128) { if (si + 1 < nseq) cg::this_grid().sync(); }
        else __syncthreads();
    }
}

extern "C" void kernel_launch(void* const* d_in, const int* in_sizes, int n_in, void* d_out, int out_size, void* d_ws, size_t ws_size, hipStream_t stream) {
    static int grid = 0;
    if (grid == 0) {
        if (n_in != 29 || out_size != T * DM || ws_size < WS_END) { fprintf(stderr, "kernel_launch: unexpected shapes (n_in %d out %d ws %zu need %zu)\n", n_in, out_size, ws_size, (size_t)WS_END); grid = -1; return; }
        int dev = 0, cus = 0, per_cu = 0;
        hipGetDevice(&dev);
        hipDeviceGetAttribute(&cus, hipDeviceAttributeMultiprocessorCount, dev);
        if (hipFuncSetAttribute((const void*)mega, hipFuncAttributeMaxDynamicSharedMemorySize, LDS_BYTES) != hipSuccess) { fprintf(stderr, "kernel_launch: hipFuncSetAttribute failed\n"); grid = -1; return; }
        if (hipOccupancyMaxActiveBlocksPerMultiprocessor(&per_cu, (const void*)mega, 512, LDS_BYTES) != hipSuccess || per_cu < 1) per_cu = 1;
        (void)hipGetLastError();
        grid = cus * per_cu;
    }
    if (grid < 0) return;
    P p{};
    const float** f = (const float**)&p;
    for (int i = 0; i < 29; ++i) f[i] = (const float*)d_in[i];
    p.out = (float*)d_out;
    unsigned char* ws = (unsigned char*)d_ws;
    p.X = (bf16_t*)(ws + OFF_X); p.Y = (bf16_t*)(ws + OFF_Y); p.ZA = (bf16_t*)(ws + OFF_ZA); p.V = (bf16_t*)(ws + OFF_V); p.W = (bf16_t*)(ws + OFF_W);
    p.ss_in = (float*)(ws + OFF_SSI); p.ss_ffn = (float*)(ws + OFF_SSF);
    int ns = 0;
#define EMIT(op, l, sync) p.seq[ns++] = ((op) | ((l) << 5) | ((sync) ? 128 : 0))
    EMIT(OP_XCONV, 0, 0); EMIT(OP_WCONV, 0, 1);
    for (int l = 0; l < NLAYER; ++l) {
        EMIT(OP_GEMM_IN, l, 0); EMIT(OP_FILTERGEN, l, 1);
        EMIT(OP_ATTN, l, 0); EMIT(OP_HPRE, l, 0);
        if (l + 1 < NLAYER) { EMIT(OP_FFFT, l, 0); EMIT(OP_WCONV, l + 1, 1); } else EMIT(OP_FFFT, l, 1);
#if PROBE_MASK & 1
        EMIT(OP_ATTN, l, 1);
#endif
#if PROBE_MASK & 2
        EMIT(OP_HPRE, l, 1);
#endif
#if PROBE_MASK & 4
        EMIT(OP_FILTERGEN, l, 1); EMIT(OP_FFFT, l, 1);
#endif
#if PROBE_MASK & 8
        if (l + 1 < NLAYER) EMIT(OP_WCONV, l + 1, 1);
#endif
        EMIT(OP_FFTCONV, l, 1);
#if PROBE_MASK & 16
        EMIT(OP_HPRE, l, 1); EMIT(OP_FFTCONV, l, 1);
#endif
        EMIT(OP_MIXFINAL, l, 1);
#if PROBE_MASK & 32
        EMIT(OP_ATTN, l, 1); EMIT(OP_MIXFINAL, l, 1);
#endif
        EMIT(OP_GEMM_OUT, l, 0); EMIT(OP_PCONV, l, 1);
#if PROBE_MASK & 128
        for (int r = 0; r < 4; ++r) EMIT(OP_PCONV, l, 1);
#endif
        EMIT(OP_GEMM_UP, l, 1);
#if PROBE_MASK & 64
        EMIT(OP_GEMM_UP, l, 1);
#endif
        EMIT(OP_GEMM_DOWN, l, 1);
        EMIT(OP_GEMM_GATE, l, 0);
        EMIT(OP_GEMM_PROJ, l, 1);
    }
#undef EMIT
    p.nseq = ns;
    void* args[] = {&p};
    hipError_t e = hipLaunchCooperativeKernel((const void*)mega, dim3(grid), dim3(512), args, LDS_BYTES, stream);
    if (e != hipSuccess) fprintf(stderr, "cooperative launch failed: %s (grid %d)\n", hipGetErrorString(e), grid);
}
```
